# Optimizing an MI355X kernel written in HIP

```python
import math
import jax
import jax.numpy as jnp
from jax import lax
import numpy as np

D_MODEL = 2048
BATCH = 2
SEQ = 16384
DEPTH = 2

HEAD_DIM = 128
A_HEADS = 8
A_KV_HEADS = 2
B_HEADS = 8
B_PATTERNS = ((128, 1), (512, 4), (2048, 16))
C_HEADS = 8
C_VALUE_DIM = 2 * HEAD_DIM
D_FF_DENSE = 5632
N_EXPERTS = 8
TOP_K = 2
D_FF_EXPERT = 7168
MOE_BLOCK = 2048
Q_BLOCK = 128
GRID_W = 64
ROPE_THETA = 10000.0
NORM_EPS = 1e-6
NEG_INF = -1e30
A_Q_DIM = A_HEADS * HEAD_DIM
A_KV_DIM = A_KV_HEADS * HEAD_DIM
B_DIM = B_HEADS * HEAD_DIM
L0_IN_DIM = A_Q_DIM + 2 * A_KV_DIM + 3 * B_DIM
L0_MIX_DIM = A_Q_DIM + B_DIM
C_QK_DIM = C_HEADS * 2 * HEAD_DIM
C_V_DIM = C_HEADS * C_VALUE_DIM
L1_IN_DIM = 2 * C_QK_DIM + C_V_DIM

kernel_name = "hybrid_gqa_dilated_diffattn_moe_encoder"


def rms_norm(x, g):
    xf = x.astype(jnp.float32)
    y = xf * lax.rsqrt(jnp.mean(xf * xf, axis=-1, keepdims=True) + NORM_EPS)
    return (y * g.astype(jnp.float32)).astype(x.dtype)


def alibi_slopes(n_heads):
    return 2.0 ** (-8.0 * jnp.arange(1, n_heads + 1, dtype=jnp.float32) / n_heads)


def axial_rope_angles(S):
    rows = S // GRID_W
    row = jnp.broadcast_to(jnp.arange(rows, dtype=jnp.float32)[:, None], (rows, GRID_W)).reshape(S)
    col = jnp.broadcast_to(jnp.arange(GRID_W, dtype=jnp.float32)[None, :], (rows, GRID_W)).reshape(S)
    n_freq = HEAD_DIM // 4
    inv = ROPE_THETA ** (-jnp.arange(n_freq, dtype=jnp.float32) / n_freq)
    return row[:, None] * inv, col[:, None] * inv


def rope_half(x, ang):
    c = jnp.cos(ang)[:, None, :]
    s = jnp.sin(ang)[:, None, :]
    x1, x2 = jnp.split(x, 2, axis=-1)
    return jnp.concatenate([x1 * c - x2 * s, x2 * c + x1 * s], axis=-1)


def apply_axial_rope(x, ang_row, ang_col):
    xf = x.astype(jnp.float32)
    half = HEAD_DIM // 2
    out = jnp.concatenate([rope_half(xf[..., :half], ang_row), rope_half(xf[..., half:], ang_col)], axis=-1)
    return out.astype(x.dtype)


def gqa_attention(q, k, v):
    B, S, Hq, Dh = q.shape
    Hkv = k.shape[2]
    G = Hq // Hkv
    nb = S // Q_BLOCK
    scale = Dh ** -0.5
    qb = q.reshape(B, nb, Q_BLOCK, Hkv, G, Dh).transpose(1, 0, 2, 3, 4, 5)

    def block(q_blk):
        s = jnp.einsum('bqhgd,bkhd->bhgqk', q_blk, k, preferred_element_type=jnp.float32) * scale
        p = jax.nn.softmax(s, axis=-1)
        return jnp.einsum('bhgqk,bkhd->bqhgd', p.astype(v.dtype), v)

    o = lax.map(block, qb)
    return o.transpose(1, 0, 2, 3, 4, 5).reshape(B, S, Hq, Dh)


def dilated_window_attention(q, k, v, slopes, window, dil):
    B, S, H, Dh = q.shape
    L = S // dil
    R = window // (2 * dil)
    W = R
    nb = -(-L // W)
    Lp = nb * W
    BD = B * dil
    scale = Dh ** -0.5

    def to_sub(t):
        return t.reshape(B, L, dil, H, Dh).transpose(0, 2, 1, 3, 4).reshape(BD, L, H, Dh)

    def key_blocks(t):
        tp = jnp.pad(to_sub(t), ((0, 0), (W, Lp - L + W), (0, 0), (0, 0))).reshape(BD, nb + 2, W, H, Dh)
        return jnp.concatenate([tp[:, :-2], tp[:, 1:-1], tp[:, 2:]], axis=2)

    qs = jnp.pad(to_sub(q), ((0, 0), (0, Lp - L), (0, 0), (0, 0))).reshape(BD, nb, W, H, Dh)
    kb = key_blocks(k)
    vb = key_blocks(v)
    rel = jnp.arange(3 * W)[None, :] - W - jnp.arange(W)[:, None]
    kidx = jnp.arange(nb)[:, None] * W - W + jnp.arange(3 * W)[None, :]
    valid = (jnp.abs(rel) <= R)[None] & ((kidx >= 0) & (kidx < L))[:, None, :]
    bias = -slopes[:, None, None] * (dil * jnp.abs(rel)).astype(jnp.float32)[None]
    s = jnp.einsum('znqhd,znkhd->znhqk', qs, kb, preferred_element_type=jnp.float32) * scale
    s = jnp.where(valid[None, :, None], s + bias[None, None], NEG_INF)
    m = jnp.max(s, axis=-1, keepdims=True)
    p = jnp.exp(s - m)
    l = jnp.sum(p, axis=-1, keepdims=True)
    o = jnp.einsum('znhqk,znkhd->znqhd', (p / l).astype(v.dtype), vb)
    lse = (m + jnp.log(l))[..., 0].transpose(0, 1, 3, 2)

    def from_sub(t):
        t = t[:, :L].reshape((B, dil, L) + t.shape[2:])
        t = jnp.moveaxis(t, 1, 2)
        return t.reshape((B, S) + t.shape[3:])

    return from_sub(o.reshape(BD, Lp, H, Dh)), from_sub(lse.reshape(BD, Lp, H))


def dilated_mixture_attention(q, k, v, slopes):
    outs = []
    lses = []
    for window, dil in B_PATTERNS:
        o_p, lse_p = dilated_window_attention(q, k, v, slopes, window, dil)
        outs.append(o_p)
        lses.append(lse_p)
    wts = jax.nn.softmax(jnp.stack(lses, axis=0), axis=0)
    o = jnp.einsum('pbsh,pbshd->bshd', wts, jnp.stack(outs, axis=0).astype(jnp.float32))
    return o.astype(q.dtype)


def diff_attention(q, k, v, lam, slopes):
    B, S, H, _, Dh = q.shape
    Dv = v.shape[-1]
    nb = S // Q_BLOCK
    scale = Dh ** -0.5
    kpos = jnp.arange(S, dtype=jnp.float32)
    qb = q.reshape(B, nb, Q_BLOCK, H, 2, Dh).transpose(1, 0, 2, 3, 4, 5)

    def block(args):
        q_blk, i = args
        qpos = (i * Q_BLOCK + jnp.arange(Q_BLOCK)).astype(jnp.float32)
        bias = -slopes[:, None, None] * jnp.abs(qpos[:, None] - kpos[None, :])[None]
        s = jnp.einsum('bqhcd,bkhcd->bhcqk', q_blk, k, preferred_element_type=jnp.float32) * scale
        p = jax.nn.softmax(s + bias[None, :, None], axis=-1)
        a = p[:, :, 0] - lam * p[:, :, 1]
        return jnp.einsum('bhqk,bkhd->bqhd', a.astype(v.dtype), v)

    o = lax.map(block, (qb, jnp.arange(nb)))
    return o.transpose(1, 0, 2, 3, 4).reshape(B, S, H, Dv)


def swiglu(h, w_gate, w_up, w_down):
    return (jax.nn.silu(h @ w_gate) * (h @ w_up)) @ w_down


def moe_swiglu(h, w_router, e_gate, e_up, e_down):
    T, D = h.shape
    logits = jnp.einsum('td,de->te', h, w_router, preferred_element_type=jnp.float32)
    top_val, top_idx = lax.top_k(logits, TOP_K)
    gates = jax.nn.softmax(top_val, axis=-1).astype(h.dtype)
    A = T * TOP_K
    a_exp = top_idx.reshape(A).astype(jnp.int32)
    a_tok = jnp.repeat(jnp.arange(T, dtype=jnp.int32), TOP_K)
    a_gate = gates.reshape(A)
    s_exp, s_tok, s_gate = lax.sort((a_exp, a_tok, a_gate), dimension=0, is_stable=True, num_keys=1)
    counts = jnp.bincount(a_exp, length=N_EXPERTS)
    padded = (counts + MOE_BLOCK - 1) // MOE_BLOCK * MOE_BLOCK
    start = jnp.cumsum(counts) - counts
    pend = jnp.cumsum(padded)
    pstart = pend - padded
    dest = pstart[s_exp] + jnp.arange(A, dtype=jnp.int32) - start[s_exp]
    n_blocks = -(-A // MOE_BLOCK) + N_EXPERTS
    P = n_blocks * MOE_BLOCK
    buf_tok = jnp.full((P,), T, jnp.int32).at[dest].set(s_tok)
    buf_gate = jnp.zeros((P,), h.dtype).at[dest].set(s_gate)
    blk_exp = jnp.minimum(jnp.searchsorted(pend, jnp.arange(n_blocks, dtype=jnp.int32) * MOE_BLOCK, side='right'), N_EXPERTS - 1)
    h_pad = jnp.concatenate([h, jnp.zeros((1, D), h.dtype)], axis=0)
    xs = h_pad[buf_tok].reshape(n_blocks, MOE_BLOCK, D)

    def expert_block(args):
        xb, e = args
        return (jax.nn.silu(xb @ e_gate[e]) * (xb @ e_up[e])) @ e_down[e]

    ys = lax.map(expert_block, (xs, blk_exp)).reshape(P, D)
    return jax.ops.segment_sum(ys * buf_gate[:, None], buf_tok, num_segments=T + 1)[:T]


def even_layer(x, norm_mix, w_in, qn_a, kn_a, qn_b, kn_b, w_out, norm_ffn, w_gate, w_up, w_down):
    B, S, _ = x.shape
    h = rms_norm(x, norm_mix)
    proj = jnp.einsum('bsd,de->bse', h, w_in)
    splits = np.cumsum([A_Q_DIM, A_KV_DIM, A_KV_DIM, B_DIM, B_DIM]).tolist()
    q_a, k_a, v_a, q_b, k_b, v_b = jnp.split(proj, splits, axis=-1)
    ang_row, ang_col = axial_rope_angles(S)
    q_a = apply_axial_rope(rms_norm(q_a.reshape(B, S, A_HEADS, HEAD_DIM), qn_a), ang_row, ang_col)
    k_a = apply_axial_rope(rms_norm(k_a.reshape(B, S, A_KV_HEADS, HEAD_DIM), kn_a), ang_row, ang_col)
    o_a = gqa_attention(q_a, k_a, v_a.reshape(B, S, A_KV_HEADS, HEAD_DIM))
    q_b = rms_norm(q_b.reshape(B, S, B_HEADS, HEAD_DIM), qn_b)
    k_b = rms_norm(k_b.reshape(B, S, B_HEADS, HEAD_DIM), kn_b)
    o_b = dilated_mixture_attention(q_b, k_b, v_b.reshape(B, S, B_HEADS, HEAD_DIM), alibi_slopes(B_HEADS))
    mix = jnp.concatenate([o_a.reshape(B, S, A_Q_DIM), o_b.reshape(B, S, B_DIM)], axis=-1)
    x = x + jnp.einsum('bse,ed->bsd', mix, w_out)
    return x + swiglu(rms_norm(x, norm_ffn), w_gate, w_up, w_down)


def odd_layer(x, layer, norm_mix, w_in, qn_c, kn_c, lam_q1, lam_k1, lam_q2, lam_k2, subln, w_out,
              norm_ffn, w_router, e_gate, e_up, e_down):
    B, S, D = x.shape
    h = rms_norm(x, norm_mix)
    proj = jnp.einsum('bsd,de->bse', h, w_in)
    q, k, v = jnp.split(proj, [C_QK_DIM, 2 * C_QK_DIM], axis=-1)
    q = rms_norm(q.reshape(B, S, C_HEADS, 2, HEAD_DIM), qn_c)
    k = rms_norm(k.reshape(B, S, C_HEADS, 2, HEAD_DIM), kn_c)
    v = v.reshape(B, S, C_HEADS, C_VALUE_DIM)
    lambda_init = 0.8 - 0.6 * math.exp(-0.3 * layer)
    f32 = jnp.float32
    lam = (jnp.exp(jnp.sum(lam_q1.astype(f32) * lam_k1.astype(f32)))
           - jnp.exp(jnp.sum(lam_q2.astype(f32) * lam_k2.astype(f32))) + lambda_init)
    o = diff_attention(q, k, v, lam, alibi_slopes(C_HEADS))
    o = rms_norm(o, subln) * (1.0 - lambda_init)
    x = x + jnp.einsum('bse,ed->bsd', o.reshape(B, S, C_V_DIM), w_out)
    hf = rms_norm(x, norm_ffn).reshape(B * S, D)
    return x + moe_swiglu(hf, w_router, e_gate, e_up, e_down).reshape(B, S, D)


def setup_inputs(seed: int = 0) -> dict:
    key = jax.random.key(seed)
    ks = iter(list(jax.random.split(key, 32)))

    def w(shape, fan_in):
        return jax.random.normal(next(ks), shape, jnp.float32) * (fan_in ** -0.5)

    def gain(n):
        return 1.0 + 0.02 * jax.random.normal(next(ks), (n,), jnp.float32)

    def small(shape, s):
        return s * jax.random.normal(next(ks), shape, jnp.float32)

    return {
        'x': jax.random.normal(next(ks), (BATCH, SEQ, D_MODEL), jnp.float32),
        'l0_norm_mix': gain(D_MODEL),
        'l0_w_in': w((D_MODEL, L0_IN_DIM), D_MODEL),
        'l0_qnorm_a': gain(HEAD_DIM),
        'l0_knorm_a': gain(HEAD_DIM),
        'l0_qnorm_b': gain(HEAD_DIM),
        'l0_knorm_b': gain(HEAD_DIM),
        'l0_w_out': w((L0_MIX_DIM, D_MODEL), L0_MIX_DIM),
        'l0_norm_ffn': gain(D_MODEL),
        'l0_w_gate': w((D_MODEL, D_FF_DENSE), D_MODEL),
        'l0_w_up': w((D_MODEL, D_FF_DENSE), D_MODEL),
        'l0_w_down': w((D_FF_DENSE, D_MODEL), D_FF_DENSE),
        'l1_norm_mix': gain(D_MODEL),
        'l1_w_in': w((D_MODEL, L1_IN_DIM), D_MODEL),
        'l1_qnorm_c': gain(HEAD_DIM),
        'l1_knorm_c': gain(HEAD_DIM),
        'l1_lambda_q1': small((HEAD_DIM,), 0.1),
        'l1_lambda_k1': small((HEAD_DIM,), 0.1),
        'l1_lambda_q2': small((HEAD_DIM,), 0.1),
        'l1_lambda_k2': small((HEAD_DIM,), 0.1),
        'l1_subln': gain(C_VALUE_DIM),
        'l1_w_out': w((C_V_DIM, D_MODEL), C_V_DIM),
        'l1_norm_ffn': gain(D_MODEL),
        'l1_w_router': w((D_MODEL, N_EXPERTS), D_MODEL),
        'l1_e_gate': w((N_EXPERTS, D_MODEL, D_FF_EXPERT), D_MODEL),
        'l1_e_up': w((N_EXPERTS, D_MODEL, D_FF_EXPERT), D_MODEL),
        'l1_e_down': w((N_EXPERTS, D_FF_EXPERT, D_MODEL), D_FF_EXPERT),
    }


def reference(x, l0_norm_mix, l0_w_in, l0_qnorm_a, l0_knorm_a, l0_qnorm_b, l0_knorm_b, l0_w_out,
              l0_norm_ffn, l0_w_gate, l0_w_up, l0_w_down,
              l1_norm_mix, l1_w_in, l1_qnorm_c, l1_knorm_c, l1_lambda_q1, l1_lambda_k1,
              l1_lambda_q2, l1_lambda_k2, l1_subln, l1_w_out, l1_norm_ffn, l1_w_router,
              l1_e_gate, l1_e_up, l1_e_down):
    for layer in range(DEPTH):
        if layer % 2 == 0:
            x = even_layer(x, l0_norm_mix, l0_w_in, l0_qnorm_a, l0_knorm_a, l0_qnorm_b, l0_knorm_b,
                           l0_w_out, l0_norm_ffn, l0_w_gate, l0_w_up, l0_w_down)
        else:
            x = odd_layer(x, layer, l1_norm_mix, l1_w_in, l1_qnorm_c, l1_knorm_c, l1_lambda_q1,
                          l1_lambda_k1, l1_lambda_q2, l1_lambda_k2, l1_subln, l1_w_out,
                          l1_norm_ffn, l1_w_router, l1_e_gate, l1_e_up, l1_e_down)
    return x
```

```cpp
#include <hip/hip_runtime.h>
#include <cstdio>
#include <cstdint>
namespace pg8 {
#define PG8_LAS __attribute__((address_space(3)))
typedef unsigned short bf16_t;
typedef short bf16x8 __attribute__((ext_vector_type(8)));
typedef float f32x4 __attribute__((ext_vector_type(4)));
typedef unsigned u32x4 __attribute__((ext_vector_type(4)));
constexpr int BM = 256, BK = 64, HALF = 128, HTB = HALF * BK * 2  , STAGE_BYTES = 8 * HTB, NXCD = 8, WGM = 8;

__host__ __device__ __forceinline__ int lds_byte(int r, int c) { const int st = (r >> 4) * 2 + (c >> 5), rr = r & 15, cc = c & 31, ob = rr * 64 + cc * 2; return st * 1024 + (ob ^ (((ob >> 9) & 1) << 5)); }
__host__ __device__ __forceinline__ void stage_rc(int b, int& R, int& C) { const int st = b / 1024, sb = b % 1024, swz = sb ^ (((sb >> 9) & 1) << 5); R = (st >> 1) * 16 + swz / 64; C = (st & 1) * 32 + (swz % 64) / 2; }
__host__ __device__ __forceinline__ int perm32(int rho) { const int n = rho >> 4, i = rho & 15; return 8 * (i >> 2) + 4 * n + (i & 3); }

struct Unit { int pm, pn; };
struct Gemm { const bf16_t* A; const bf16_t* Bt; int M, N, K; };

struct StaticOrder {
    int nM, nN, nwg, G, c;
    __host__ __device__ void init(int M, int N, int G_, int c_) { nM = M / BM; nN = N / BM; nwg = nM * nN; G = G_; c = c_; }
    __host__ __device__ bool next(int i, Unit& u) const {
        const long L = (long)i * G + c; if (L >= nwg) return false;
        int wgid = (int)L; { const int q = nwg / NXCD, r = nwg % NXCD, xcd = wgid % NXCD, off = wgid / NXCD; wgid = (xcd < r ? xcd * (q + 1) : r * (q + 1) + (xcd - r) * q) + off; }
        const int nig = WGM * nN, gid = wgid / nig, fm = gid * WGM, gsz = (nM - fm) < WGM ? (nM - fm) : WGM;
        u.pm = fm + ((wgid % nig) % gsz); u.pn = (wgid % nig) / gsz; return true;
    }
    __device__ __forceinline__ void a_ready(const Unit&) const {}
    __device__ __forceinline__ void done(const Unit&) const {}
    __device__ __forceinline__ size_t b_extra(const Unit&) const { return 0; }
};
struct MoeOrder : StaticOrder {
    int t0; int cend[8]; size_t estride;
    __device__ __forceinline__ size_t b_extra(const Unit& u) const { const int pa = t0 + u.pm; int e = 0;
#pragma unroll
        for (int k = 0; k < 7; ++k) e += (pa >= cend[k]) ? 1 : 0;
        return (size_t)e * estride; }
};

__device__ __forceinline__ unsigned cvt_pk_bf16(float lo, float hi) { unsigned r; asm volatile("v_cvt_pk_bf16_f32 %0, %1, %2" : "=v"(r) : "v"(lo), "v"(hi)); return r; }

struct EpiBf16 {
    static constexpr bool PERM = true, AFTER_DRAIN = false;
    bf16_t* O; int ldc;
    __device__ __forceinline__ void operator()(const f32x4 (&acc)[2][2][4][2], const Unit& u, int wr, int wc, int fr, int fq) const {
        const int row0 = u.pm * BM + wr * 64 + fr; const int col0 = u.pn * BM + wc * 32 + 8 * fq;
#pragma unroll
        for (int ai = 0; ai < 2; ++ai)
#pragma unroll
            for (int m = 0; m < 4; ++m) { bf16_t* rowp = O + (size_t)(row0 + ai * HALF + m * 16) * ldc + col0;
#pragma unroll
                for (int bj = 0; bj < 2; ++bj) { const f32x4 v0 = acc[ai][bj][m][0], v1 = acc[ai][bj][m][1];
                    u32x4 w; w.x = cvt_pk_bf16(v0[0], v0[1]); w.y = cvt_pk_bf16(v0[2], v0[3]); w.z = cvt_pk_bf16(v1[0], v1[1]); w.w = cvt_pk_bf16(v1[2], v1[3]);
                    *(u32x4*)(rowp + bj * HALF) = w; } }
    }
};
__device__ __forceinline__ float silu_mul(float g, float u) { const float e = __builtin_amdgcn_exp2f(g * -1.4426950408889634f); return g * u * __builtin_amdgcn_rcpf(1.0f + e); }
struct EpiSwiglu {
    static constexpr bool PERM = true, AFTER_DRAIN = false;
    bf16_t* O; int ldc;
    __device__ __forceinline__ void operator()(const f32x4 (&acc)[2][2][4][2], const Unit& u, int wr, int wc, int fr, int fq) const {
        const int row0 = u.pm * BM + wr * 64 + fr; const int col0 = u.pn * HALF + wc * 32 + 8 * fq;
#pragma unroll
        for (int ai = 0; ai < 2; ++ai)
#pragma unroll
            for (int m = 0; m < 4; ++m) { bf16_t* rowp = O + (size_t)(row0 + ai * HALF + m * 16) * ldc + col0;
                const f32x4 g0 = acc[ai][0][m][0], g1 = acc[ai][0][m][1], u0 = acc[ai][1][m][0], u1 = acc[ai][1][m][1];
                u32x4 w; w.x = cvt_pk_bf16(silu_mul(g0[0], u0[0]), silu_mul(g0[1], u0[1])); w.y = cvt_pk_bf16(silu_mul(g0[2], u0[2]), silu_mul(g0[3], u0[3]));
                w.z = cvt_pk_bf16(silu_mul(g1[0], u1[0]), silu_mul(g1[1], u1[1])); w.w = cvt_pk_bf16(silu_mul(g1[2], u1[2]), silu_mul(g1[3], u1[3]));
                *(u32x4*)rowp = w; }
    }
};
struct EpiRes {
    static constexpr bool PERM = false, AFTER_DRAIN = false;
    const float* base; float* out; int ldc;
    __device__ __forceinline__ void operator()(const f32x4 (&acc)[2][2][4][2], const Unit& u, int wr, int wc, int fr, int fq) const {
        const int col0 = u.pn * BM + wc * 32 + 4 * fq;
#pragma unroll
        for (int ai = 0; ai < 2; ++ai)
#pragma unroll
            for (int m = 0; m < 4; ++m) { const size_t off = (size_t)(u.pm * BM + ai * HALF + wr * 64 + m * 16 + fr) * ldc + col0;
#pragma unroll
                for (int bj = 0; bj < 2; ++bj)
#pragma unroll
                    for (int n = 0; n < 2; ++n) { const f32x4 bs = *(const f32x4*)(base + off + bj * HALF + n * 16); *(f32x4*)(out + off + bj * HALF + n * 16) = bs + acc[ai][bj][m][n]; }
                if (m & 1) asm volatile("" ::: "memory"); }
    }
};

template <class Epi, class Sched, bool ALIGN_EPI = false, bool SP2 = false>
__device__ __forceinline__ void gemm_phase(PG8_LAS unsigned char* lds, const Gemm g, const Sched& S, const Epi& E) {
    int tid = threadIdx.x; asm volatile("" : "+v"(tid));
    const int wid = __builtin_amdgcn_readfirstlane(tid >> 6), lane = tid & 63, wr = wid >> 2, wc = wid & 3, fr = lane & 15, fq = lane >> 4;
    const int K = g.K, nt = K / BK;
    unsigned voffA[2], voffB[2];
#pragma unroll
    for (int i = 0; i < 2; ++i) { int R, C; stage_rc(tid * 16 + i * 8192, R, C); const int Rb = Epi::PERM ? ((R & ~31) + perm32(R & 31)) : R;
        voffA[i] = (unsigned)(R * K + C) * 2u; voffB[i] = (unsigned)(Rb * K + C) * 2u; }
    const size_t kstep = (size_t)(BK * 2);
    const size_t hstep = (size_t)HALF * K * 2;
    const size_t tstep = 2 * hstep;
    const unsigned ldsw = (unsigned)wid * 1024u;
    const int aoff = lds_byte(wr * 64 + fr, fq * 8), boff = lds_byte(wc * 32 + fr, fq * 8);
#define PG8_SA(b, h) (((b) * 2 + (h)) * HTB)
#define PG8_SB(b, h) ((4 + (b) * 2 + (h)) * HTB)
#define PG8_STAGE(bufoff, gbase, voff) do { _Pragma("unroll") for (int _i = 0; _i < 2; ++_i) \
        __builtin_amdgcn_global_load_lds((const unsigned*)((const char*)(gbase) + (voff)[_i]), (PG8_LAS unsigned*)(lds + (bufoff) + ldsw + _i * 8192), 16, 0, 0); } while (0)
#define PG8_LDA(dst, b, h) do { _Pragma("unroll") for (int m = 0; m < 4; ++m) _Pragma("unroll") for (int k = 0; k < 2; ++k) dst[m][k] = *(const PG8_LAS bf16x8*)(lds + PG8_SA(b, h) + aoff + m * 2048 + k * 1024); } while (0)
#define PG8_LDB(dst, b, h) do { _Pragma("unroll") for (int n = 0; n < 2; ++n) _Pragma("unroll") for (int k = 0; k < 2; ++k) dst[n][k] = *(const PG8_LAS bf16x8*)(lds + PG8_SB(b, h) + boff + n * 2048 + k * 1024); } while (0)
#define PG8_MMA(ai, bj, At, Bt) do { __builtin_amdgcn_s_setprio(1); _Pragma("unroll") for (int m = 0; m < 4; ++m) _Pragma("unroll") for (int n = 0; n < 2; ++n) _Pragma("unroll") for (int k = 0; k < 2; ++k) \
        acc[ai][bj][m][n] = __builtin_amdgcn_mfma_f32_16x16x32_bf16(Bt[n][k], At[m][k], acc[ai][bj][m][n], 0, 0, 0); __builtin_amdgcn_s_setprio(0); } while (0)
#define PG8_WAIT_V(n) asm volatile("s_waitcnt vmcnt(" #n ")" ::: "memory")
#define PG8_WAIT_L(n) asm volatile("s_waitcnt lgkmcnt(" #n ")" ::: "memory")
#define PG8_BAR __builtin_amdgcn_s_barrier()
#define PG8_SCHED __builtin_amdgcn_sched_barrier(0)
    Unit cur, nxt; int ui = 0;
    if (!S.next(0, cur)) return;
    f32x4 acc[2][2][4][2];
#pragma unroll
    for (int a = 0; a < 2; ++a)
#pragma unroll
        for (int b = 0; b < 2; ++b)
#pragma unroll
            for (int m = 0; m < 4; ++m)
#pragma unroll
                for (int n = 0; n < 2; ++n) acc[a][b][m][n] = (f32x4){0.f, 0.f, 0.f, 0.f};
    bf16x8 At[4][2], B0[2][2], B1[2][2];
    const char* cA = (const char*)g.A + (size_t)cur.pm * tstep; const char* cB = (const char*)g.Bt + S.b_extra(cur) + (size_t)cur.pn * tstep;
    S.a_ready(cur);
    if constexpr (SP2) {
        PG8_STAGE(PG8_SB(0, 0), cB, voffB); PG8_STAGE(PG8_SB(0, 1), cB + hstep, voffB); PG8_STAGE(PG8_SA(0, 0), cA, voffA); PG8_STAGE(PG8_SA(0, 1), cA + hstep, voffA);
        if (wr == 1) PG8_BAR;
        PG8_WAIT_V(2); PG8_BAR;
        PG8_STAGE(PG8_SB(1, 0), cB + kstep, voffB); PG8_STAGE(PG8_SA(1, 0), cA + kstep, voffA); PG8_STAGE(PG8_SB(1, 1), cB + hstep + kstep, voffB);
        PG8_WAIT_V(6); PG8_BAR;
    } else {
        PG8_STAGE(PG8_SB(0, 0), cB, voffB); PG8_STAGE(PG8_SA(0, 0), cA, voffA); PG8_STAGE(PG8_SB(0, 1), cB + hstep, voffB); PG8_STAGE(PG8_SA(0, 1), cA + hstep, voffA);
        if (wr == 1) PG8_BAR;
        PG8_WAIT_V(4); PG8_BAR;
        PG8_STAGE(PG8_SB(1, 0), cB + kstep, voffB); PG8_STAGE(PG8_SA(1, 0), cA + kstep, voffA); PG8_STAGE(PG8_SB(1, 1), cB + hstep + kstep, voffB);
        PG8_WAIT_V(6); PG8_BAR;
    }
    for (;;) {
        const bool has_next = S.next(ui + 1, nxt);
        const char* nA = has_next ? (const char*)g.A + (size_t)nxt.pm * tstep : cA; const char* nB = has_next ? (const char*)g.Bt + S.b_extra(nxt) + (size_t)nxt.pn * tstep : cB;
        for (int t = 0; t < nt; t += 2) {
            const bool last = (t == nt - 2);
            const char* a1 = cA + (size_t)(t + 1) * kstep;
            const char* a2 = last ? nA : cA + (size_t)(t + 2) * kstep; const char* b2 = last ? nB : cB + (size_t)(t + 2) * kstep;
            const char* a3 = a2 + kstep; const char* b3 = b2 + kstep;
            if (last && has_next) S.a_ready(nxt);
            if constexpr (SP2) {
            PG8_LDB(B0, 0, 0); PG8_LDB(B1, 0, 1); PG8_SCHED; PG8_LDA(At, 0, 0); PG8_STAGE(PG8_SA(1, 1), a1 + hstep, voffA);
            PG8_WAIT_V(8); PG8_WAIT_L(0); PG8_BAR; PG8_MMA(0, 0, At, B0); PG8_MMA(0, 1, At, B1); PG8_BAR; PG8_SCHED;
            PG8_LDA(At, 0, 1); PG8_STAGE(PG8_SB(0, 0), b2, voffB); PG8_STAGE(PG8_SB(0, 1), b2 + hstep, voffB); PG8_STAGE(PG8_SA(0, 0), a2, voffA);
            PG8_WAIT_V(8); PG8_WAIT_L(0); PG8_BAR; PG8_MMA(1, 0, At, B0); PG8_MMA(1, 1, At, B1); PG8_BAR; PG8_SCHED;
            PG8_LDB(B0, 1, 0); PG8_LDB(B1, 1, 1); PG8_SCHED; PG8_LDA(At, 1, 0); PG8_STAGE(PG8_SA(0, 1), a2 + hstep, voffA);
            PG8_WAIT_V(8); PG8_WAIT_L(0); PG8_BAR; PG8_MMA(0, 0, At, B0); PG8_MMA(0, 1, At, B1); PG8_BAR; PG8_SCHED;
            PG8_LDA(At, 1, 1); PG8_STAGE(PG8_SB(1, 0), b3, voffB); PG8_STAGE(PG8_SB(1, 1), b3 + hstep, voffB); PG8_STAGE(PG8_SA(1, 0), a3, voffA);
            PG8_WAIT_V(8); PG8_WAIT_L(0); PG8_BAR; PG8_MMA(1, 0, At, B0); PG8_MMA(1, 1, At, B1); PG8_BAR; PG8_SCHED;
            } else {
            PG8_LDB(B0, 0, 0); PG8_SCHED; PG8_LDA(At, 0, 0); PG8_STAGE(PG8_SA(1, 1), a1 + hstep, voffA);
            PG8_WAIT_L(8); PG8_BAR; PG8_WAIT_L(0); PG8_MMA(0, 0, At, B0); PG8_BAR; PG8_SCHED;
            PG8_LDB(B1, 0, 1); PG8_STAGE(PG8_SB(0, 0), b2, voffB);
            PG8_BAR; PG8_WAIT_L(0); PG8_MMA(0, 1, At, B1); PG8_BAR;
            PG8_LDA(At, 0, 1); PG8_STAGE(PG8_SA(0, 0), a2, voffA);
            PG8_BAR; PG8_WAIT_L(0); PG8_MMA(1, 0, At, B0); PG8_BAR; PG8_SCHED;
            PG8_STAGE(PG8_SB(0, 1), b2 + hstep, voffB);
            PG8_WAIT_V(6); PG8_BAR; PG8_MMA(1, 1, At, B1); PG8_BAR;
            PG8_LDB(B0, 1, 0); PG8_SCHED; PG8_LDA(At, 1, 0); PG8_STAGE(PG8_SA(0, 1), a2 + hstep, voffA);
            PG8_WAIT_L(8); PG8_BAR; PG8_WAIT_L(0); PG8_MMA(0, 0, At, B0); PG8_BAR; PG8_SCHED;
            PG8_LDB(B1, 1, 1); PG8_STAGE(PG8_SB(1, 0), b3, voffB);
            PG8_BAR; PG8_WAIT_L(0); PG8_MMA(0, 1, At, B1); PG8_BAR;
            PG8_LDA(At, 1, 1); PG8_STAGE(PG8_SA(1, 0), a3, voffA);
            PG8_BAR; PG8_WAIT_L(0); PG8_MMA(1, 0, At, B0); PG8_BAR; PG8_SCHED;
            PG8_STAGE(PG8_SB(1, 1), b3 + hstep, voffB);
            PG8_WAIT_V(6); PG8_BAR; PG8_MMA(1, 1, At, B1); PG8_BAR;
            }
        }
        if constexpr (ALIGN_EPI) { if (wr == 0) PG8_BAR; }
        if constexpr (!Epi::AFTER_DRAIN) { E(acc, cur, wr, wc, fr, fq); S.done(cur); }
        if (!has_next) break;
#pragma unroll
        for (int a = 0; a < 2; ++a)
#pragma unroll
            for (int b = 0; b < 2; ++b)
#pragma unroll
                for (int m = 0; m < 4; ++m)
#pragma unroll
                    for (int n = 0; n < 2; ++n) acc[a][b][m][n] = (f32x4){0.f, 0.f, 0.f, 0.f};
        cur = nxt; cA = nA; cB = nB; ++ui;
        if constexpr (ALIGN_EPI) { if (wr == 1) PG8_BAR; }
    }
    PG8_WAIT_V(0);
    if constexpr (!ALIGN_EPI) { if (wr == 0) PG8_BAR; }
    PG8_BAR;
    if constexpr (Epi::AFTER_DRAIN) { E.fused(acc, cur, wr, wc, fr, fq, lds, wid, lane); S.done(cur); }
#undef PG8_SA
#undef PG8_SB
#undef PG8_STAGE
#undef PG8_LDA
#undef PG8_LDB
#undef PG8_MMA
#undef PG8_WAIT_V
#undef PG8_WAIT_L
#undef PG8_BAR
#undef PG8_SCHED
}
}
namespace att {
using bf16x8 = __attribute__((ext_vector_type(8))) short;
using s16x4  = __attribute__((ext_vector_type(4))) short;
using f32x16 = __attribute__((ext_vector_type(16))) float;
using u32x4  = __attribute__((ext_vector_type(4))) unsigned;
typedef unsigned short bf16;
constexpr int   D = 128, NW = 8, QBLK = 32, KVBLK = 64;
constexpr float SCALE = 0.088388347648318440f;
constexpr float THR = 8.f;
constexpr size_t SHM_V = KVBLK * D * 2, SHM_K = KVBLK * D * 2, SHM_ATTN = 2 * SHM_V + 2 * SHM_K + NW * 64 * 4;
#define KSWZ(row, colB) ((row) * 256 + ((colB) ^ (((row) & 7) << 4)))
#define SBAR() __builtin_amdgcn_sched_barrier(0)
__device__ __forceinline__ int crow(int r, int hi) { return (r & 3) + 8 * (r >> 2) + 4 * hi; }
__device__ __forceinline__ unsigned cvtpk(float lo, float hi) { unsigned r; asm volatile("v_cvt_pk_bf16_f32 %0, %1, %2" : "=v"(r) : "v"(lo), "v"(hi)); return r; }

__device__ __forceinline__ void partialSM(f32x16& p0, f32x16& p1, float& m_reg, float& mn, float& alpha) {
  constexpr float C = SCALE * 1.4426950408889634f;
  float pmax = p0[0];
#pragma unroll
  for (int r = 1; r < 16; ++r) pmax = fmaxf(pmax, p0[r]);
#pragma unroll
  for (int r = 0; r < 16; ++r) pmax = fmaxf(pmax, p1[r]);
  { auto rr = __builtin_amdgcn_permlane32_swap(__float_as_uint(pmax), __float_as_uint(pmax), false, false);
    pmax = fmaxf(__uint_as_float(rr[0]), __uint_as_float(rr[1])); }
  if (__builtin_expect(__all(pmax - m_reg <= THR / SCALE), 1)) { mn = m_reg; alpha = 1.f; }
  else { mn = fmaxf(m_reg, pmax); alpha = __builtin_amdgcn_exp2f((m_reg - mn) * C); m_reg = mn; }
  const float mnC = -mn * C;
#pragma unroll
  for (int r = 0; r < 16; ++r) p0[r] = fmaf(p0[r], C, mnC);
#pragma unroll
  for (int r = 0; r < 16; ++r) p1[r] = fmaf(p1[r], C, mnC);
#pragma unroll
  for (int r = 0; r < 16; ++r) p0[r] = __builtin_amdgcn_exp2f(p0[r]);
}
__device__ __forceinline__ void finishSM(f32x16& p0, f32x16& p1, float alpha, float& l_reg, bf16x8& pa0, bf16x8& pa1, bf16x8& pa2, bf16x8& pa3) {
#pragma unroll
  for (int r = 0; r < 16; ++r) p1[r] = __builtin_amdgcn_exp2f(p1[r]);
  float ps = 0;
#pragma unroll
  for (int r = 0; r < 16; ++r) ps += p0[r];
#pragma unroll
  for (int r = 0; r < 16; ++r) ps += p1[r];
  { auto rr = __builtin_amdgcn_permlane32_swap(__float_as_uint(ps), __float_as_uint(ps), false, false);
    ps = __uint_as_float(rr[0]) + __uint_as_float(rr[1]); }
  l_reg = l_reg * alpha + ps;
#define PK4(P, BASE, OUT) do { unsigned a0 = cvtpk(P[BASE + 0], P[BASE + 1]), a1 = cvtpk(P[BASE + 2], P[BASE + 3]);   \
    unsigned b0 = cvtpk(P[BASE + 4], P[BASE + 5]), b1 = cvtpk(P[BASE + 6], P[BASE + 7]);                              \
    auto r0 = __builtin_amdgcn_permlane32_swap(a0, b0, false, false); auto r1 = __builtin_amdgcn_permlane32_swap(a1, b1, false, false); \
    u32x4 w = {r0[0], r1[0], r0[1], r1[1]}; OUT = *reinterpret_cast<bf16x8*>(&w); } while (0)
  PK4(p0, 0, pa0); PK4(p0, 8, pa1); PK4(p1, 0, pa2); PK4(p1, 8, pa3);
#undef PK4
}
template <int MODE>
__device__ __forceinline__ void qkt(f32x16& p0, f32x16& p1, const char* Ks, const bf16x8* qr, int r32, int hi, float dq, float slopeS) {
  if constexpr (MODE == 0) { p0 = f32x16{}; p1 = f32x16{}; }
  else {
#pragma unroll
    for (int r = 0; r < 16; ++r) { const float d0 = dq - (float)((r & 3) + 8 * (r >> 2)), d1 = d0 - 32.f;
      p0[r] = __builtin_fabsf(d0) * -slopeS; p1[r] = __builtin_fabsf(d1) * -slopeS;
      if constexpr (MODE == 2) { if (__builtin_fabsf(d0) > 64.f) p0[r] = -__builtin_inff(); if (__builtin_fabsf(d1) > 64.f) p1[r] = -__builtin_inff(); } }
  }
#pragma unroll
  for (int d0 = 0; d0 < 8; ++d0) { const int cb = (d0 * 16 + hi * 8) * 2;
    bf16x8 b0 = *reinterpret_cast<const bf16x8*>(Ks + KSWZ(r32, cb));
    bf16x8 b1 = *reinterpret_cast<const bf16x8*>(Ks + KSWZ(32 + r32, cb));
    p0 = __builtin_amdgcn_mfma_f32_32x32x16_bf16(b0, qr[d0], p0, 0, 0, 0);
    p1 = __builtin_amdgcn_mfma_f32_32x32x16_bf16(b1, qr[d0], p1, 0, 0, 0); }
}
__device__ __forceinline__ int v_st(int k, int c) { const int kk = (k & ~0xC) | ((k & 4) << 1) | ((k & 8) >> 1); return ((kk >> 3) * 4 + (c >> 5)) * 512 + ((kk & 7) * 32 + (c & 31)) * 2; }
__device__ __forceinline__ int v_rd_base(int lane) { return ((lane & 3) << 3) | (((lane >> 2) & 3) << 6) | (((lane >> 4) & 1) << 5) | (((lane >> 5) & 1) << 8); }
constexpr int v_rd_off(int d0, int ks, int half) { return d0 * 512 + ks * 4096 + half * 2048; }
template <int OFF> __device__ __forceinline__ s16x4 tr_read(int vb) {
  s16x4 r; asm volatile("ds_read_b64_tr_b16 %0, %1 offset:%2" : "=&v"(r) : "v"(vb), "i"(OFF) : "memory"); return r;
}
template <int D0> __device__ __forceinline__ void pv_one(f32x16& od, int vb, bf16x8 pa0, bf16x8 pa1, bf16x8 pa2, bf16x8 pa3) {
  const s16x4 l0 = tr_read<v_rd_off(D0, 0, 0)>(vb), h0 = tr_read<v_rd_off(D0, 0, 1)>(vb), l1 = tr_read<v_rd_off(D0, 1, 0)>(vb), h1 = tr_read<v_rd_off(D0, 1, 1)>(vb);
  const s16x4 l2 = tr_read<v_rd_off(D0, 2, 0)>(vb), h2 = tr_read<v_rd_off(D0, 2, 1)>(vb), l3 = tr_read<v_rd_off(D0, 3, 0)>(vb), h3 = tr_read<v_rd_off(D0, 3, 1)>(vb);
  asm volatile("s_waitcnt lgkmcnt(0)" ::: "memory"); SBAR();
#define PK(L, H) (bf16x8){L[0], L[1], L[2], L[3], H[0], H[1], H[2], H[3]}
  od = __builtin_amdgcn_mfma_f32_32x32x16_bf16(pa0, PK(l0, h0), od, 0, 0, 0);
  od = __builtin_amdgcn_mfma_f32_32x32x16_bf16(pa1, PK(l1, h1), od, 0, 0, 0);
  od = __builtin_amdgcn_mfma_f32_32x32x16_bf16(pa2, PK(l2, h2), od, 0, 0, 0);
  od = __builtin_amdgcn_mfma_f32_32x32x16_bf16(pa3, PK(l3, h3), od, 0, 0, 0);
#undef PK
}
__device__ __forceinline__ void pv_d0(f32x16* o, int vb, bf16x8 pa0, bf16x8 pa1, bf16x8 pa2, bf16x8 pa3) {
  pv_one<0>(o[0], vb, pa0, pa1, pa2, pa3); pv_one<1>(o[1], vb, pa0, pa1, pa2, pa3); pv_one<2>(o[2], vb, pa0, pa1, pa2, pa3); pv_one<3>(o[3], vb, pa0, pa1, pa2, pa3);
}

template <int MODE, int SD>
__device__ __forceinline__ void attn_unit(const bf16* __restrict__ Qb, int ldq, const bf16* __restrict__ Kh, const bf16* __restrict__ Vh, int ldk,
                                          bf16* __restrict__ Ob, int ldo_, float* __restrict__ lse_out, int lse_stride_, int NT, float dq0, float slopeS, char* lds) {
  int tid = threadIdx.x; asm volatile("" : "+v"(tid));
  const int wid = __builtin_amdgcn_readfirstlane(tid >> 6), lane = tid & 63, r32 = lane & 31, hi = lane >> 5;
  char* V_lds = lds; char* K_lds = lds + 2 * SHM_V;
  float* ws = (float*)(lds + 2 * SHM_V + 2 * SHM_K) + wid * 64; float* li_l = ws; float* al_l = ws + 32;
  float m_reg = -1e30f, l_reg = 0; f32x16 o[4] = {}; bf16x8 qr[8];
  const bf16* Qw = Qb + (unsigned)((wid * QBLK + r32) * ldq + hi * 8);
#pragma unroll
  for (int d0 = 0; d0 < 8; ++d0) qr[d0] = *reinterpret_cast<const bf16x8*>(Qw + d0 * 16);
  const int sr = tid >> 4, sc = (tid & 15) * 8, vst0 = v_st(sr, sc), vst1 = v_st(32 + sr, sc);
  const int vb0 = (int)(uintptr_t)V_lds + v_rd_base(lane);
  const float dqb = dq0 + (float)(wid * QBLK + r32 - 4 * hi);
  struct { bf16x8 vs0, vs1, ks0, ks1; } sr_[SD];
#define SLOAD(i, k0) do { sr_[i].vs0 = *reinterpret_cast<const bf16x8*>(&Vh[(unsigned)(((k0) + sr) * ldk + sc)]); sr_[i].vs1 = *reinterpret_cast<const bf16x8*>(&Vh[(unsigned)(((k0) + 32 + sr) * ldk + sc)]); \
    sr_[i].ks0 = *reinterpret_cast<const bf16x8*>(&Kh[(unsigned)(((k0) + sr) * ldk + sc)]); sr_[i].ks1 = *reinterpret_cast<const bf16x8*>(&Kh[(unsigned)(((k0) + 32 + sr) * ldk + sc)]); } while (0)
#define SWRITE(b, i) do { *(bf16x8*)(V_lds + (b) * SHM_V + vst0) = sr_[i].vs0;          \
    *(bf16x8*)(V_lds + (b) * SHM_V + vst1) = sr_[i].vs1; const int kc = sc * 2;               \
    *(bf16x8*)(K_lds + (b) * SHM_K + KSWZ(sr, kc)) = sr_[i].ks0;                       \
    *(bf16x8*)(K_lds + (b) * SHM_K + KSWZ(32 + sr, kc)) = sr_[i].ks1; } while (0)
#define SWAIT() do { if constexpr (SD == 2) asm volatile("s_waitcnt vmcnt(4)" ::: "memory"); else asm volatile("s_waitcnt vmcnt(0)" ::: "memory"); } while (0)
#define RESC(a) do { if (__any((a) < 1.f)) { if (hi == 0) al_l[r32] = (a); asm volatile("s_waitcnt lgkmcnt(0)" ::: "memory"); \
    _Pragma("unroll") for (int d = 0; d < 4; ++d) _Pragma("unroll") for (int r = 0; r < 16; ++r) o[d][r] *= al_l[crow(r, hi)]; } } while (0)
  f32x16 pA0, pA1, pB0, pB1; float mnA, mnB, alA, alB; bf16x8 pa0, pa1, pa2, pa3;
  constexpr int SE = 0, SO = SD - 1;
  SLOAD(SE, 0); asm volatile("s_waitcnt vmcnt(0)" ::: "memory"); SWRITE(0, SE); __syncthreads();
  qkt<MODE>(pA0, pA1, K_lds, qr, r32, hi, dqb, slopeS); partialSM(pA0, pA1, m_reg, mnA, alA);
  SLOAD(SO, KVBLK); if constexpr (SD == 2) { if (2 < NT) SLOAD(SE, 2 * KVBLK); }
  SWAIT(); SWRITE(1, SO); __syncthreads();
  for (int j = 1; j + 1 < NT; j += 2) {
    SBAR(); qkt<MODE>(pB0, pB1, K_lds + SHM_K, qr, r32, hi, dqb - (float)(j * KVBLK), slopeS);
    finishSM(pA0, pA1, alA, l_reg, pa0, pa1, pa2, pa3); SBAR();
    SLOAD(SO, (j + SD) * KVBLK); SBAR();
    pv_d0(o, vb0, pa0, pa1, pa2, pa3); partialSM(pB0, pB1, m_reg, mnB, alB);
    __syncthreads(); SWAIT(); SWRITE(0, SE);
    RESC(alB); __syncthreads();
    SBAR(); qkt<MODE>(pA0, pA1, K_lds, qr, r32, hi, dqb - (float)((j + 1) * KVBLK), slopeS);
    finishSM(pB0, pB1, alB, l_reg, pa0, pa1, pa2, pa3); SBAR();
    if (SD == 1 || j + 3 < NT) SLOAD(SE, (j + 1 + SD) * KVBLK); SBAR();
    pv_d0(o, vb0 + (int)SHM_V, pa0, pa1, pa2, pa3); partialSM(pA0, pA1, m_reg, mnA, alA);
    __syncthreads(); SWAIT(); SWRITE(1, SO);
    RESC(alA); __syncthreads();
  }
  SBAR(); qkt<MODE>(pB0, pB1, K_lds + SHM_K, qr, r32, hi, dqb - (float)((NT - 1) * KVBLK), slopeS);
  finishSM(pA0, pA1, alA, l_reg, pa0, pa1, pa2, pa3); SBAR();
  pv_d0(o, vb0, pa0, pa1, pa2, pa3); partialSM(pB0, pB1, m_reg, mnB, alB);
  __syncthreads(); RESC(alB);
  finishSM(pB0, pB1, alB, l_reg, pa0, pa1, pa2, pa3); SBAR();
  pv_d0(o, vb0 + (int)SHM_V, pa0, pa1, pa2, pa3);
  if (hi == 0) li_l[r32] = l_reg; asm volatile("s_waitcnt lgkmcnt(0)" ::: "memory");
  float rli[16];
#pragma unroll
  for (int r = 0; r < 16; ++r) rli[r] = __builtin_amdgcn_rcpf(li_l[crow(r, hi)]);
  int ldo = ldo_; asm volatile("" : "+s"(ldo));
  bf16* Ow = Ob + (unsigned)((wid * QBLK) * ldo);
#pragma unroll
  for (int r = 0; r < 16; ++r) { const int orow = crow(r, hi);
#pragma unroll
    for (int d0 = 0; d0 < 4; ++d0) { const float v = o[d0][r] * rli[r]; unsigned u = __builtin_bit_cast(unsigned, v); u = (u + 0x7fffu + ((u >> 16) & 1u)) >> 16; Ow[(unsigned)(orow * ldo + d0 * 32 + r32)] = (bf16)u; } }
  if constexpr (MODE == 2) { int lse_stride = lse_stride_; asm volatile("" : "+s"(lse_stride)); if (hi == 0) lse_out[(unsigned)((wid * QBLK + r32) * lse_stride)] = m_reg * SCALE + __logf(l_reg); }
#undef SLOAD
#undef SWRITE
#undef SWAIT
#undef RESC
}
#undef KSWZ
#undef SBAR
}

#define GAS __attribute__((address_space(1)))
#define LAS __attribute__((address_space(3)))
typedef unsigned short bf16;
typedef unsigned v4u __attribute__((ext_vector_type(4)));
typedef float f32x4 __attribute__((ext_vector_type(4)));
typedef short bf16x8 __attribute__((ext_vector_type(8)));
typedef GAS unsigned gu32;
typedef GAS unsigned long long gu64;
#define RLX_AGENT __ATOMIC_RELAXED, __HIP_MEMORY_SCOPE_AGENT
#define LDS_WAIT() asm volatile("s_waitcnt lgkmcnt(0)" ::: "memory")
#define VM_WAIT() asm volatile("s_waitcnt vmcnt(0)" ::: "memory")
__device__ __forceinline__ unsigned long long rt() { return __builtin_amdgcn_s_memrealtime(); }
__device__ __forceinline__ unsigned f2bf(float f) { unsigned u = __builtin_bit_cast(unsigned, f); return (u + 0x7fffu + ((u >> 16) & 1u)) >> 16; }
__device__ __forceinline__ unsigned pk2(float lo, float hi) { return f2bf(lo) | (f2bf(hi) << 16); }

#define XB_TMO      128
#define XB_XCNT(j)  (256  + 64 * (j))
#define XB_XSUB(j)  (1280 + 64 * (j))
#define XB_XGEN(j)  (2304 + 64 * (j))
#define XB_TOP      3328
#define XB_TOPGEN   3392
#define XCD_BAR_WORDS 3456
#define XB_SPIN_CAP (1u << 18)

__device__ __forceinline__ unsigned xb_ld(unsigned* p)              { return __hip_atomic_load(p, __ATOMIC_RELAXED, __HIP_MEMORY_SCOPE_AGENT); }
__device__ __forceinline__ unsigned xb_add(unsigned* p, unsigned v) { return __hip_atomic_fetch_add(p, v, __ATOMIC_RELAXED, __HIP_MEMORY_SCOPE_AGENT); }
__device__ __forceinline__ unsigned xb_xcc_id() { return (unsigned)__builtin_amdgcn_s_getreg((3 << 11) | 20) & 0xFu; }
#define XB_SPIN(cond, bar) do { unsigned _sp = 0; while (cond) { __builtin_amdgcn_s_sleep(1); \
    if ((++_sp & 255u) == 0u) { if (xb_ld(&(bar)[XB_TMO])) break; if (_sp > XB_SPIN_CAP) { atomicAdd(&(bar)[XB_TMO], 1u); break; } } } } while (0)

struct XcdBarrier {
    unsigned* bar; unsigned x;
    volatile LAS unsigned* st;
};

__device__ __forceinline__ XcdBarrier xcd_barrier_post(unsigned* bar, volatile LAS unsigned* st) {
    XcdBarrier b; b.bar = bar; b.x = xb_xcc_id(); b.st = st;
    if (threadIdx.x == 0) (void)xb_add(&bar[XB_XCNT(b.x)], 1u);
    return b;
}
__device__ __forceinline__ void xcd_barrier_complete(unsigned* bar, unsigned x, unsigned& nloc, unsigned& nx) {
    const unsigned G = gridDim.x * gridDim.y * gridDim.z;
    unsigned sum, cnt, mine, sp = 0u;
    for (;;) {
        sum = 0u; cnt = 0u; mine = 0u;
#pragma unroll
        for (unsigned j = 0; j < 16; ++j) { const unsigned c = xb_ld(&bar[XB_XCNT(j)]); sum += c; cnt += (c > 0u) ? 1u : 0u; mine = (j == x) ? c : mine; }
        if (sum == G) break;
        __builtin_amdgcn_s_sleep(1);
        if ((++sp & 255u) == 0u) { if (xb_ld(&bar[XB_TMO])) break; if (sp > XB_SPIN_CAP) { atomicAdd(&bar[XB_TMO], 1u); break; } }
    }
    nloc = mine > 0u ? mine : 1u; nx = cnt > 0u ? cnt : 1u;
}

__device__ __forceinline__ void xcd_barrier(const XcdBarrier& b) {
    asm volatile("s_waitcnt vmcnt(0)" ::: "memory");
    __syncthreads();
    if (threadIdx.x == 0) {
        unsigned* bar = b.bar;
        __builtin_amdgcn_s_waitcnt(0);
        unsigned nloc = b.st[0], nx = b.st[1];
        if (nloc == 0u) { xcd_barrier_complete(bar, b.x, nloc, nx); b.st[0] = nloc; b.st[1] = nx; }
        const unsigned old = xb_add(&bar[XB_XSUB(b.x)], 1u);
        const unsigned gen = old / nloc;
        if (old + 1u == (gen + 1u) * nloc) {
            __builtin_amdgcn_fence(__ATOMIC_RELEASE, "agent");
            asm volatile("s_waitcnt vmcnt(0)" ::: "memory");
            const unsigned og = xb_add(&bar[XB_TOP], 1u);
            const unsigned tg = og / nx;
            if (og + 1u == (tg + 1u) * nx) xb_add(&bar[XB_TOPGEN], 1u);
            else XB_SPIN(xb_ld(&bar[XB_TOPGEN]) == tg, bar);
            __builtin_amdgcn_fence(__ATOMIC_ACQUIRE, "agent");
            xb_add(&bar[XB_XGEN(b.x)], 1u);
            asm volatile("s_waitcnt vmcnt(0)" ::: "memory");
        } else {
            XB_SPIN(xb_ld(&bar[XB_XGEN(b.x)]) == gen, bar);
            __builtin_amdgcn_fence(__ATOMIC_ACQUIRE, "agent");
            asm volatile("s_waitcnt vmcnt(0)" ::: "memory");
        }
    }
    __syncthreads();
}
#ifndef ATT_SD0
#define ATT_SD0 1
#endif
#ifndef ATT_SD1
#define ATT_SD1 2
#endif
#ifndef ATT_SD2
#define ATT_SD2 2
#endif
constexpr int NWAVES = 8;
constexpr int BATCH = 2, SEQ = 16384, DM = 2048, T = BATCH * SEQ, HD = 128;
constexpr int L0_IN = 4608, L1_IN = 6144, FF0 = 5632, FFE = 7168, NE = 8;
constexpr float NORM_EPS = 1e-6f;
constexpr float LAMBDA_INIT = 0.35550906759096927f;
constexpr int P_MAX_TILES = 264;
constexpr int MOE_ROUND_TILES = 132;
#ifndef MK_N_LAUNCHES
#define MK_N_LAUNCHES 22
#endif
constexpr int N_PHASES = 22;
constexpr int N_LAUNCHES = MK_N_LAUNCHES;
static_assert(N_LAUNCHES == 1 || N_LAUNCHES == N_PHASES, "MK_N_LAUNCHES is 1 or N_PHASES");

constexpr size_t MiB = 1u << 20;
constexpr size_t WS_CTL = 0, CTL_ZERO_BYTES = 1 * MiB;
constexpr size_t WS_ROPE = 1 * MiB;
constexpr size_t WS_CNT = 1 * MiB + 128 * 1024;
constexpr size_t WS_TOT = 1 * MiB + 192 * 1024;
constexpr size_t WS_TOKE = 2 * MiB;
constexpr size_t WS_TOKG = 3 * MiB;
constexpr size_t WS_TOKS = 4 * MiB;
constexpr size_t WS_LSE = 5 * MiB;
constexpr size_t WS_WIN0 = 16 * MiB, WS_WOUT0 = 34 * MiB, WS_WGU0 = 42 * MiB, WS_WD0 = 86 * MiB, WS_WIN1 = 108 * MiB, WS_WOUT1 = 132 * MiB;
constexpr size_t WS_WGUE = 140 * MiB, WS_WDE = 588 * MiB;
constexpr size_t WS_ARENA = 812 * MiB, WS_END = 1840 * MiB;
constexpr size_t A_H = 0, A_PROJ0 = 128 * MiB, A_OB = 416 * MiB, A_MIX = 608 * MiB;
constexpr size_t A_ACT0 = 128 * MiB;
constexpr size_t A_PROJ1 = 128 * MiB, A_OC = 512 * MiB;
constexpr size_t A_XS = 0, A_ACT = 264 * MiB, A_HFB = 264 * MiB, A_Y = 726 * MiB;
static_assert(A_Y + (size_t)P_MAX_TILES * 256 * DM * 2 <= WS_END - WS_ARENA && A_ACT + (size_t)MOE_ROUND_TILES * 256 * FFE * 2 <= A_Y && A_XS + (size_t)P_MAX_TILES * 256 * DM * 2 <= A_ACT, "arena map (MoE)");
static_assert(A_MIX + (size_t)T * DM * 2 <= WS_END - WS_ARENA && A_OC + 2 * (size_t)T * DM * 2 <= WS_END - WS_ARENA && A_ACT0 + (size_t)T * FF0 * 2 <= WS_END - WS_ARENA, "arena map");
static_assert(WS_WDE + (size_t)NE * DM * FFE * 2 <= WS_ARENA && WS_WGUE + (size_t)NE * 2 * FFE * DM * 2 <= WS_WDE && WS_WOUT1 + (size_t)DM * DM * 2 <= WS_WGUE, "weight map");
constexpr int CW_TMO = 0, CW_CODE = 1;
constexpr int CW_BAR = 4096;
constexpr int CW_Q0 = 8192, CW_Q1 = 8192 + 64, CW_Q2 = 8192 + 128;

constexpr int RING_OFF = 0, RING_BYTES = 131072;
constexpr int LDSCTL_OFF = RING_BYTES, MISC_OFF = LDSCTL_OFF + 320;
constexpr int LDS_BYTES = 147456;
static_assert(MISC_OFF + 128 <= LDS_BYTES, "LDS map");

struct Frame {
    LAS unsigned char* lds;
    volatile LAS unsigned* MISC;
    gu32* ctl;
    int vcu, G;
};
typedef float f32x2 __attribute__((ext_vector_type(2)));
typedef int i32x2 __attribute__((ext_vector_type(2)));

__device__ __forceinline__ float wave_sum(float v) {
#pragma unroll
    for (int o = 1; o < 64; o <<= 1) v += __shfl_xor(v, o);
    return v;
}
__device__ __forceinline__ float bflo(unsigned w) { return __uint_as_float(w << 16); }
__device__ __forceinline__ float bfhi(unsigned w) { return __uint_as_float(w & 0xffff0000u); }
__device__ __forceinline__ void unpack8(const v4u w, float (&v)[8]) { v[0] = bflo(w.x); v[1] = bfhi(w.x); v[2] = bflo(w.y); v[3] = bfhi(w.y); v[4] = bflo(w.z); v[5] = bfhi(w.z); v[6] = bflo(w.w); v[7] = bfhi(w.w); }
__device__ __forceinline__ v4u pack8(const float (&v)[8]) { v4u w; w.x = pk2(v[0], v[1]); w.y = pk2(v[2], v[3]); w.z = pk2(v[4], v[5]); w.w = pk2(v[6], v[7]); return w; }

__device__ __forceinline__ void transpose_item(const float* __restrict__ W, int N, bf16* __restrict__ WT, size_t ldt, int k0, int n0, int drow0, LAS float* scr, int lane) {
#pragma unroll 8
    for (int i = 0; i < 32; ++i) { const int kk = 2 * i + (lane >> 5); scr[kk * 33 + (lane & 31)] = W[(size_t)(k0 + kk) * N + n0 + (lane & 31)]; }
    LDS_WAIT(); asm volatile("" ::: "memory");
    const int c = lane & 7;
#pragma unroll
    for (int j = 0; j < 4; ++j) { const int n = (lane >> 3) + 8 * j; const LAS float* s = scr + (8 * c) * 33 + n;
        v4u o; o.x = pk2(s[0 * 33], s[1 * 33]); o.y = pk2(s[2 * 33], s[3 * 33]); o.z = pk2(s[4 * 33], s[5 * 33]); o.w = pk2(s[6 * 33], s[7 * 33]);
        *(v4u*)(WT + (size_t)(drow0 + n) * ldt + k0 + 8 * c) = o; }
    LDS_WAIT(); asm volatile("" ::: "memory");
}
__device__ __forceinline__ void tr_plain(const float* W, int K, int N, bf16* WT, int r, LAS float* scr, int lane) {
    const int nblk = N / 32, kb = r / nblk, nb = r % nblk; transpose_item(W, N, WT, (size_t)K, 64 * kb, 32 * nb, 32 * nb, scr, lane);
}
__device__ __forceinline__ void tr_gu(const float* W, int K, int N, bf16* WT, int half, int r, LAS float* scr, int lane) {
    const int nblk = N / 32, kb = r / nblk, nb = r % nblk, n0 = 32 * nb; transpose_item(W, N, WT, (size_t)K, 64 * kb, n0, (n0 >> 7) * 256 + half * 128 + (n0 & 127), scr, lane);
}
__device__ __forceinline__ void rms_row_to_bf16(const float* __restrict__ xrow, const float* __restrict__ g, bf16* __restrict__ orow, int lane) {
    const f32x4* xr = (const f32x4*)xrow + lane;
    f32x4 v[8]; float s = 0.f;
#pragma unroll
    for (int j = 0; j < 8; ++j) { v[j] = xr[64 * j]; s += (v[j].x * v[j].x + v[j].y * v[j].y) + (v[j].z * v[j].z + v[j].w * v[j].w); }
    const float rstd = rsqrtf(wave_sum(s) * (1.f / DM) + NORM_EPS);
    const f32x4* gr = (const f32x4*)g + lane;
    unsigned long long* o8 = (unsigned long long*)orow + lane;
#pragma unroll
    for (int j = 0; j < 8; ++j) { const f32x4 gg = gr[64 * j];
        o8[64 * j] = (unsigned long long)pk2(v[j].x * rstd * gg.x, v[j].y * rstd * gg.y) | ((unsigned long long)pk2(v[j].z * rstd * gg.z, v[j].w * rstd * gg.w) << 32); }
}
__device__ __forceinline__ void norm_rows_phase(int gw, int NGW, int lane, const float* x, const float* g, bf16* Hd) {
    for (int m = gw; m < T; m += NGW) rms_row_to_bf16(x + (size_t)m * DM, g, Hd + (size_t)m * DM, lane);
}

struct Args { const float* in[27]; float* out; unsigned char* ws; int ph_lo, ph_hi; };
static_assert(sizeof(Args) == 27 * 8 + 8 + 8 + 8, "Args has no padding");

#define AS4 __attribute__((address_space(4)))
#define PH_BEGIN int tid = threadIdx.x; asm volatile("" : "+v"(tid)); const int lane = tid & 63, wave = __builtin_amdgcn_readfirstlane(tid >> 6), gw = F.vcu * NWAVES + wave, NGW = F.G * NWAVES; (void)lane; (void)gw; (void)NGW; \
    const AS4 unsigned char* kp = (const AS4 unsigned char*)__builtin_amdgcn_kernarg_segment_ptr(); asm volatile("" : "+s"(kp)); \
    unsigned char* const wsb = *(unsigned char* const AS4*)(kp + 224); unsigned char* const arena = wsb + WS_ARENA; float* const outp = *(float* const AS4*)(kp + 216); (void)arena; (void)outp
#define INP(k) (*(const float* const AS4*)(kp + 8 * (k)))
#define W_IN0 ((bf16*)(wsb + WS_WIN0))
#define W_OUT0 ((bf16*)(wsb + WS_WOUT0))
#define W_GU0 ((bf16*)(wsb + WS_WGU0))
#define W_D0 ((bf16*)(wsb + WS_WD0))
#define W_IN1 ((bf16*)(wsb + WS_WIN1))
#define W_OUT1 ((bf16*)(wsb + WS_WOUT1))
#define W_GUE ((bf16*)(wsb + WS_WGUE))
#define W_DE ((bf16*)(wsb + WS_WDE))
#define H ((bf16*)(arena + A_H))
#define PROJ0 ((bf16*)(arena + A_PROJ0))
#define OB ((bf16*)(arena + A_OB))
#define MIX ((bf16*)(arena + A_MIX))
#define ACT0 ((bf16*)(arena + A_ACT0))
#define PROJ1 ((bf16*)(arena + A_PROJ1))
#define OC ((bf16*)(arena + A_OC))
#define XS ((bf16*)(arena + A_XS))
#define ACT ((bf16*)(arena + A_ACT))
#define HFB ((bf16*)(arena + A_HFB))
#define Y ((bf16*)(arena + A_Y))
#define ROPE ((f32x2*)(wsb + WS_ROPE))
#define LSE ((float*)(wsb + WS_LSE))
#define CNT ((int*)(wsb + WS_CNT))
#define TOT ((int*)(wsb + WS_TOT))
#define TOKE ((i32x2*)(wsb + WS_TOKE))
#define TOKG ((f32x2*)(wsb + WS_TOKG))
#define TOKS ((i32x2*)(wsb + WS_TOKS))
__global__ void __launch_bounds__(NWAVES * 64, 2) mk_fwd(Args args) {
    extern __shared__ __attribute__((aligned(16))) unsigned char lds[];
    Frame F;
    F.lds = (LAS unsigned char*)lds;
    F.MISC = (volatile LAS unsigned*)(F.lds + MISC_OFF);
    F.G = gridDim.x; { const int bx = blockIdx.x; F.vcu = (F.G % 8 == 0) ? (bx % 8) * (F.G / 8) + bx / 8 : bx; }
    { const AS4 unsigned char* kp0 = (const AS4 unsigned char*)__builtin_amdgcn_kernarg_segment_ptr(); F.ctl = (gu32*)(*(unsigned char* const AS4*)(kp0 + 224) + WS_CTL); }
    for (int u = threadIdx.x; u < (LDS_BYTES - LDSCTL_OFF) / 4; u += NWAVES * 64) ((LAS unsigned*)(F.lds + LDSCTL_OFF))[u] = 0u;
    __syncthreads();
    XcdBarrier bar; bar.bar = (unsigned*)(F.ctl + CW_BAR); bar.x = 0; bar.st = nullptr;
    if (N_LAUNCHES == 1) bar = xcd_barrier_post((unsigned*)(F.ctl + CW_BAR), F.MISC + 8);
#define GRID_BAR() do { if (N_LAUNCHES == 1) { xcd_barrier(bar); } } while (0)
    int lo, hi; { const AS4 unsigned char* kp0 = (const AS4 unsigned char*)__builtin_amdgcn_kernarg_segment_ptr(); lo = *(const AS4 int*)(kp0 + 232); hi = *(const AS4 int*)(kp0 + 236); }
#ifndef PH_MASK
#define PH_MASK 0xffffffffu
#endif
#define IN(k) (((PH_MASK >> (k)) & 1u) && lo <= (k) && (k) < hi)
#define SEAM(k) do { if (IN(k) && IN((k) + 1)) GRID_BAR(); } while (0)
    if (IN(0)) {
        PH_BEGIN;
        LAS float* scr = (LAS float*)(F.lds + RING_OFF + wave * 16384);
        constexpr int I0 = (DM / 64) * (L0_IN / 32), I1 = (DM / 64) * (DM / 32), I2 = (DM / 64) * (FF0 / 32), I4 = (FF0 / 64) * (DM / 32), I5 = (DM / 64) * (L1_IN / 32);
        constexpr int IE = (DM / 64) * (FFE / 32), IED = (FFE / 64) * (DM / 32);
        constexpr int NITEMS = I0 + I1 + 2 * I2 + I4 + I5 + I1 + NE * (2 * IE + IED);
        for (int it = gw; it < NITEMS; it += NGW) {
            int r = it;
            if (r < I0) { tr_plain(INP(2), DM, L0_IN, W_IN0, r, scr, lane); continue; } r -= I0;
            if (r < I1) { tr_plain(INP(7), DM, DM, W_OUT0, r, scr, lane); continue; } r -= I1;
            if (r < I2) { tr_gu(INP(9), DM, FF0, W_GU0, 0, r, scr, lane); continue; } r -= I2;
            if (r < I2) { tr_gu(INP(10), DM, FF0, W_GU0, 1, r, scr, lane); continue; } r -= I2;
            if (r < I4) { tr_plain(INP(11), FF0, DM, W_D0, r, scr, lane); continue; } r -= I4;
            if (r < I5) { tr_plain(INP(13), DM, L1_IN, W_IN1, r, scr, lane); continue; } r -= I5;
            if (r < I1) { tr_plain(INP(21), DM, DM, W_OUT1, r, scr, lane); continue; } r -= I1;
            if (r < NE * IE) { const int e = r / IE; tr_gu(INP(24) + (size_t)e * DM * FFE, DM, FFE, W_GUE + (size_t)e * 2 * FFE * DM, 0, r % IE, scr, lane); continue; } r -= NE * IE;
            if (r < NE * IE) { const int e = r / IE; tr_gu(INP(25) + (size_t)e * DM * FFE, DM, FFE, W_GUE + (size_t)e * 2 * FFE * DM, 1, r % IE, scr, lane); continue; } r -= NE * IE;
            { const int e = r / IED; tr_plain(INP(26) + (size_t)e * FFE * DM, FFE, DM, W_DE + (size_t)e * DM * FFE, r % IED, scr, lane); }
        }
        for (int i = blockIdx.x * (NWAVES * 64) + tid; i < 256 * 32; i += F.G * NWAVES * 64) {
            const int idx = i >> 5, f = i & 31;
            const float inv = exp2f(-(float)f * (13.287712379549449f / 32.f));
            const float ang = (float)idx * inv;
            const float k = rintf(ang * 0.15915494309189535f);
            float rr = fmaf(-k, 6.28125f, ang); rr = fmaf(-k, 1.9353071795864769e-3f, rr);
            ROPE[i] = (f32x2){cosf(rr), sinf(rr)};
        }
        norm_rows_phase(gw, NGW, lane, INP(0), INP(1), H);
    }
    SEAM(0);
    if (IN(1)) {
        PH_BEGIN;
        pg8::Gemm g{H, W_IN0, T, L0_IN, DM}; pg8::StaticOrder S; S.init(T, L0_IN, F.G, (int)blockIdx.x);
        pg8::EpiBf16 E{PROJ0, L0_IN};
        pg8::gemm_phase<pg8::EpiBf16, pg8::StaticOrder, true, true>(F.lds + RING_OFF, g, S, E);
    }
    SEAM(1);
    if (IN(2)) {
        PH_BEGIN;
        const int sub = lane >> 4, j = lane & 15;
        for (int t = gw; t < T; t += NGW) {
            const int s = t % SEQ, prow = s >> 6, pcol = s & 63;
            bf16* row = PROJ0 + (size_t)t * L0_IN;
#pragma unroll
            for (int seg = 0; seg < 4; ++seg) {
                const int col0 = seg == 0 ? 0 : seg == 1 ? 1024 : seg == 2 ? 1536 : 2560;
                const int nh = seg == 1 ? 2 : 8;
                const float* g = INP(3 + seg);
                const bool rope = seg < 2;
                const f32x4 ga = *(const f32x4*)(g + j * 8), gb = *(const f32x4*)(g + j * 8 + 4);
                for (int it = 0; it * 4 < nh; ++it) {
                    const int head = it * 4 + sub; const bool act = head < nh;
                    bf16* p = row + col0 + (act ? head : 0) * HD + j * 8;
                    const v4u w = *(const v4u*)p;
                    float v[8]; unpack8(w, v);
                    float ss = 0.f;
#pragma unroll
                    for (int i = 0; i < 8; ++i) ss += v[i] * v[i];
                    ss += __shfl_xor(ss, 1); ss += __shfl_xor(ss, 2); ss += __shfl_xor(ss, 4); ss += __shfl_xor(ss, 8);
                    const float rstd = rsqrtf(ss * (1.f / HD) + NORM_EPS);
                    v[0] *= rstd * ga.x; v[1] *= rstd * ga.y; v[2] *= rstd * ga.z; v[3] *= rstd * ga.w; v[4] *= rstd * gb.x; v[5] *= rstd * gb.y; v[6] *= rstd * gb.z; v[7] *= rstd * gb.w;
                    if (rope) {
                        const int idx = (j < 8) ? prow : pcol; const f32x4* cs = (const f32x4*)(ROPE + idx * 32 + 8 * (j & 3));
                        const float sgn = (j & 4) ? 1.f : -1.f;
#pragma unroll
                        for (int q = 0; q < 4; ++q) { const f32x4 c2 = cs[q];
                            const float pa = __shfl_xor(v[2 * q], 4), pb = __shfl_xor(v[2 * q + 1], 4);
                            v[2 * q] = v[2 * q] * c2.x + sgn * pa * c2.y; v[2 * q + 1] = v[2 * q + 1] * c2.z + sgn * pb * c2.w; }
                    }
                    if (act) *(v4u*)p = pack8(v);
                }
            }
        }
    }
    SEAM(2);
    if (IN(3)) {
        PH_BEGIN;
#ifndef P3_PART
#define P3_PART 3
#endif
        if (P3_PART & 1) {
        gu32* head = F.ctl + CW_Q0;
        for (;;) {
            __syncthreads();
            if (tid == 0) F.MISC[16] = __hip_atomic_fetch_add(head, 1u, RLX_AGENT);
            __syncthreads();
            const int u = __builtin_amdgcn_readfirstlane((int)F.MISC[16]);
            if (u >= 1024) break;
            const int g = u & 3, qb = (u >> 2) & 63, kvh = (u >> 8) & 1, b = u >> 9, hq = kvh * 4 + g;
            const bf16* base = PROJ0 + (size_t)b * SEQ * L0_IN;
            att::attn_unit<0, ATT_SD0>(base + (size_t)(qb * 256) * L0_IN + hq * HD, L0_IN, base + 1024 + kvh * HD, base + 1280 + kvh * HD, L0_IN,
                              MIX + ((size_t)b * SEQ + qb * 256) * DM + hq * HD, DM, nullptr, 0, SEQ / 64, 0.f, 0.f, (char*)lds + RING_OFF);
        }
        }
        if (P3_PART & 2) {
        gu32* head = F.ctl + CW_Q2;
        for (;;) {
            __syncthreads();
            if (tid == 0) F.MISC[16] = __hip_atomic_fetch_add(head, 1u, RLX_AGENT);
            __syncthreads();
            const int v = __builtin_amdgcn_readfirstlane((int)F.MISC[16]);
            if (v >= 3072) break;
            const int rb = v & 63, h = (v >> 6) & 7, b = (v >> 9) & 1, p = v >> 10;
            const int dil = p == 0 ? 1 : p == 1 ? 4 : 16, L = SEQ / dil, nblk = L / 256, res = rb / nblk, blk = rb % nblk;
            const int q0 = blk * 256; int ks = q0 - 64; ks = ks < 0 ? 0 : ks; ks = ks > L - 384 ? L - 384 : ks;
            const bf16* base = PROJ0 + (size_t)b * SEQ * L0_IN;
            const float slope = exp2f(-(float)(h + 1));
            att::attn_unit<2, ATT_SD2>(base + (size_t)(q0 * dil + res) * L0_IN + 1536 + h * HD, dil * L0_IN,
                              base + (size_t)(ks * dil + res) * L0_IN + 2560 + h * HD, base + (size_t)(ks * dil + res) * L0_IN + 3584 + h * HD, dil * L0_IN,
                              OB + (size_t)p * T * 1024 + ((size_t)b * SEQ + q0 * dil + res) * 1024 + h * HD, dil * 1024,
                              LSE + (size_t)p * T * 8 + ((size_t)b * SEQ + q0 * dil + res) * 8 + h, dil * 8, 6, (float)(q0 - ks), slope * (float)dil * (1.0f / att::SCALE), (char*)lds + RING_OFF);
        }
        }
    }
    SEAM(3);
    if (IN(4)) {
        PH_BEGIN;
        for (int t = gw; t < T; t += NGW) {
#pragma unroll
            for (int jj = 0; jj < 2; ++jj) { const int col = 8 * (lane + 64 * jj), h = col >> 7;
                const float l0 = LSE[(size_t)t * 8 + h], l1 = LSE[(size_t)T * 8 + (size_t)t * 8 + h], l2 = LSE[(size_t)2 * T * 8 + (size_t)t * 8 + h];
                const float mx = fmaxf(l0, fmaxf(l1, l2)); float e0 = __expf(l0 - mx), e1 = __expf(l1 - mx), e2 = __expf(l2 - mx); const float inv = 1.f / (e0 + e1 + e2); e0 *= inv; e1 *= inv; e2 *= inv;
                float a[8], b8[8], c8[8], o[8];
                unpack8(*(const v4u*)(OB + (size_t)t * 1024 + col), a); unpack8(*(const v4u*)(OB + (size_t)T * 1024 + (size_t)t * 1024 + col), b8); unpack8(*(const v4u*)(OB + (size_t)2 * T * 1024 + (size_t)t * 1024 + col), c8);
#pragma unroll
                for (int i = 0; i < 8; ++i) o[i] = e0 * a[i] + e1 * b8[i] + e2 * c8[i];
                *(v4u*)(MIX + (size_t)t * DM + 1024 + col) = pack8(o); }
        }
    }
    SEAM(4);
    if (IN(5)) {
        PH_BEGIN;
        pg8::Gemm g{MIX, W_OUT0, T, DM, DM}; pg8::StaticOrder S; S.init(T, DM, F.G, (int)blockIdx.x);
        pg8::EpiRes E{INP(0), outp, DM};
        pg8::gemm_phase<pg8::EpiRes, pg8::StaticOrder, true, true>(F.lds + RING_OFF, g, S, E);
    }
    SEAM(5);
    if (IN(6)) { PH_BEGIN; norm_rows_phase(gw, NGW, lane, outp, INP(8), H); }
    SEAM(6);
    if (IN(7)) {
        PH_BEGIN;
        pg8::Gemm g{H, W_GU0, T, 2 * FF0, DM}; pg8::StaticOrder S; S.init(T, 2 * FF0, F.G, (int)blockIdx.x);
        pg8::EpiSwiglu E{ACT0, FF0};
        pg8::gemm_phase<pg8::EpiSwiglu, pg8::StaticOrder, true, true>(F.lds + RING_OFF, g, S, E);
    }
    SEAM(7);
    if (IN(8)) {
        PH_BEGIN;
        pg8::Gemm g{ACT0, W_D0, T, DM, FF0}; pg8::StaticOrder S; S.init(T, DM, F.G, (int)blockIdx.x);
        pg8::EpiRes E{outp, outp, DM};
        pg8::gemm_phase<pg8::EpiRes, pg8::StaticOrder, true, true>(F.lds + RING_OFF, g, S, E);
    }
    SEAM(8);
    if (IN(9)) { PH_BEGIN; norm_rows_phase(gw, NGW, lane, outp, INP(12), H); }
    SEAM(9);
    if (IN(10)) {
        PH_BEGIN;
        pg8::Gemm g{H, W_IN1, T, L1_IN, DM}; pg8::StaticOrder S; S.init(T, L1_IN, F.G, (int)blockIdx.x);
        pg8::EpiBf16 E{PROJ1, L1_IN};
        pg8::gemm_phase<pg8::EpiBf16, pg8::StaticOrder, true, true>(F.lds + RING_OFF, g, S, E);
    }
    SEAM(10);
    if (IN(11)) {
        PH_BEGIN;
        const int sub = lane >> 4, j = lane & 15;
        const f32x4 qa = *(const f32x4*)(INP(14) + j * 8), qb4 = *(const f32x4*)(INP(14) + j * 8 + 4), ka = *(const f32x4*)(INP(15) + j * 8), kb4 = *(const f32x4*)(INP(15) + j * 8 + 4);
        for (int t = gw; t < T; t += NGW) {
            bf16* row = PROJ1 + (size_t)t * L1_IN;
#pragma unroll 2
            for (int it = 0; it < 8; ++it) {
                const int head = it * 4 + sub; bf16* p = row + head * HD + j * 8;
                const v4u w = *(const v4u*)p; float v[8]; unpack8(w, v);
                float ss = 0.f;
#pragma unroll
                for (int i = 0; i < 8; ++i) ss += v[i] * v[i];
                ss += __shfl_xor(ss, 1); ss += __shfl_xor(ss, 2); ss += __shfl_xor(ss, 4); ss += __shfl_xor(ss, 8);
                const float rstd = rsqrtf(ss * (1.f / HD) + NORM_EPS);
                const f32x4 ga = it < 4 ? qa : ka, gb = it < 4 ? qb4 : kb4;
                v[0] *= rstd * ga.x; v[1] *= rstd * ga.y; v[2] *= rstd * ga.z; v[3] *= rstd * ga.w; v[4] *= rstd * gb.x; v[5] *= rstd * gb.y; v[6] *= rstd * gb.z; v[7] *= rstd * gb.w;
                *(v4u*)p = pack8(v);
            }
        }
    }
    SEAM(11);
    if (IN(12)) {
        PH_BEGIN;
        float gq = 0.f, gk = 0.f;
        { const float a = fabsf(INP(14)[lane]), b2 = fabsf(INP(14)[lane + 64]), c = fabsf(INP(15)[lane]), d = fabsf(INP(15)[lane + 64]); gq = fmaxf(a, b2); gk = fmaxf(c, d);
#pragma unroll
          for (int o = 1; o < 64; o <<= 1) { gq = fmaxf(gq, __shfl_xor(gq, o)); gk = fmaxf(gk, __shfl_xor(gk, o)); } }
        const float smax = 128.f * gq * gk * att::SCALE * 1.0001f;
        gu32* head = F.ctl + CW_Q1;
        for (;;) {
            __syncthreads();
            if (tid == 0) F.MISC[16] = __hip_atomic_fetch_add(head, 1u, RLX_AGENT);
            __syncthreads();
            const int u = __builtin_amdgcn_readfirstlane((int)F.MISC[16]);
            if (u >= 4096) break;
            const int h = 7 - (u >> 9), qb = u & 63, vh = (u >> 6) & 1, c = (u >> 7) & 1, b = (u >> 8) & 1;
            const float slope = exp2f(-(float)(h + 1));
            const float wf = (2.f * smax + __logf(2.f / (slope * 5.9604645e-8f))) / slope;
            const int w = wf >= (float)SEQ ? SEQ : (int)wf + 1;
            const int q0 = qb * 256;
            int tlo = q0 - w; tlo = tlo < 0 ? 0 : tlo >> 6; int thi = q0 + 256 + w; thi = thi >= SEQ ? SEQ / 64 : (thi + 63) >> 6;
            if ((thi - tlo) & 1) { if (thi < SEQ / 64) ++thi; else --tlo; }
            const bf16* base = PROJ1 + (size_t)b * SEQ * L1_IN;
            att::attn_unit<1, ATT_SD1>(base + (size_t)q0 * L1_IN + (h * 2 + c) * HD, L1_IN,
                              base + (size_t)(tlo * 64) * L1_IN + 2048 + (h * 2 + c) * HD, base + (size_t)(tlo * 64) * L1_IN + 4096 + h * 256 + vh * HD, L1_IN,
                              OC + (size_t)c * T * DM + ((size_t)b * SEQ + q0) * DM + h * 256 + vh * HD, DM, nullptr, 0, thi - tlo, (float)(q0 - tlo * 64), slope * (1.0f / att::SCALE), (char*)lds + RING_OFF);
        }
    }
    SEAM(12);
    if (IN(13)) {
        PH_BEGIN;
        float lam;
        { const float a = INP(16)[lane] * INP(17)[lane] + INP(16)[lane + 64] * INP(17)[lane + 64], b2 = INP(18)[lane] * INP(19)[lane] + INP(18)[lane + 64] * INP(19)[lane + 64];
          lam = expf(wave_sum(a)) - expf(wave_sum(b2)) + LAMBDA_INIT; }
        for (int t = gw; t < T; t += NGW) {
#pragma unroll
            for (int jj = 0; jj < 4; ++jj) { const int col = 8 * (lane + 64 * jj);
                float a[8], b8[8], v[8]; unpack8(*(const v4u*)(OC + (size_t)t * DM + col), a); unpack8(*(const v4u*)(OC + (size_t)T * DM + (size_t)t * DM + col), b8);
                float ss = 0.f;
#pragma unroll
                for (int i = 0; i < 8; ++i) { v[i] = a[i] - lam * b8[i]; ss += v[i] * v[i]; }
                ss += __shfl_xor(ss, 1); ss += __shfl_xor(ss, 2); ss += __shfl_xor(ss, 4); ss += __shfl_xor(ss, 8); ss += __shfl_xor(ss, 16);
                const float rstd = rsqrtf(ss * (1.f / 256.f) + NORM_EPS) * (1.f - LAMBDA_INIT);
                const f32x4 ga = *(const f32x4*)(INP(20) + (col & 255)), gb = *(const f32x4*)(INP(20) + (col & 255) + 4);
                v[0] *= rstd * ga.x; v[1] *= rstd * ga.y; v[2] *= rstd * ga.z; v[3] *= rstd * ga.w; v[4] *= rstd * gb.x; v[5] *= rstd * gb.y; v[6] *= rstd * gb.z; v[7] *= rstd * gb.w;
                *(v4u*)(H + (size_t)t * DM + col) = pack8(v); }
        }
    }
    SEAM(13);
    if (IN(14)) {
        PH_BEGIN;
        pg8::Gemm g{H, W_OUT1, T, DM, DM}; pg8::StaticOrder S; S.init(T, DM, F.G, (int)blockIdx.x);
        pg8::EpiRes E{outp, outp, DM};
        pg8::gemm_phase<pg8::EpiRes, pg8::StaticOrder, true, true>(F.lds + RING_OFF, g, S, E);
    }
    SEAM(14);
    if (IN(15)) {
        PH_BEGIN;
        LAS float* WrT = (LAS float*)(F.lds + RING_OFF);
        LAS int* lcnt = (LAS int*)(F.lds + RING_OFF + 65536);
        for (int c = blockIdx.x; c < 256; c += F.G) {
            __syncthreads();
            for (int k = tid; k < DM; k += NWAVES * 64) { const f32x4 w0 = *(const f32x4*)(INP(23) + k * 8), w1 = *(const f32x4*)(INP(23) + k * 8 + 4);
                WrT[0 * DM + k] = w0.x; WrT[1 * DM + k] = w0.y; WrT[2 * DM + k] = w0.z; WrT[3 * DM + k] = w0.w; WrT[4 * DM + k] = w1.x; WrT[5 * DM + k] = w1.y; WrT[6 * DM + k] = w1.z; WrT[7 * DM + k] = w1.w; }
            if (tid < 8) lcnt[tid] = 0;
            __syncthreads();
            for (int i = wave; i < 128; i += NWAVES) {
                const int t = c * 128 + i;
                const f32x4* xr = (const f32x4*)(outp + (size_t)t * DM) + lane; const f32x4* gr = (const f32x4*)INP(22) + lane;
                f32x4 v[8]; float s = 0.f;
#pragma unroll
                for (int j = 0; j < 8; ++j) { v[j] = xr[64 * j]; s += (v[j].x * v[j].x + v[j].y * v[j].y) + (v[j].z * v[j].z + v[j].w * v[j].w); }
                const float rstd = rsqrtf(wave_sum(s) * (1.f / DM) + NORM_EPS);
                unsigned long long* o8 = (unsigned long long*)(HFB + (size_t)t * DM) + lane;
                float lg[8] = {0.f, 0.f, 0.f, 0.f, 0.f, 0.f, 0.f, 0.f};
#pragma unroll
                for (int j = 0; j < 8; ++j) { const f32x4 gg = gr[64 * j]; f32x4 hv; hv.x = v[j].x * rstd * gg.x; hv.y = v[j].y * rstd * gg.y; hv.z = v[j].z * rstd * gg.z; hv.w = v[j].w * rstd * gg.w;
                    o8[64 * j] = (unsigned long long)pk2(hv.x, hv.y) | ((unsigned long long)pk2(hv.z, hv.w) << 32);
#pragma unroll
                    for (int e = 0; e < 8; ++e) { const f32x4 wv = *(const LAS f32x4*)(WrT + e * DM + 4 * (lane + 64 * j)); lg[e] += (hv.x * wv.x + hv.y * wv.y) + (hv.z * wv.z + hv.w * wv.w); } }
#pragma unroll
                for (int e = 0; e < 8; ++e) lg[e] = wave_sum(lg[e]);
                int e0 = 0; float v0 = lg[0];
#pragma unroll
                for (int e = 1; e < 8; ++e) if (lg[e] > v0) { v0 = lg[e]; e0 = e; }
                int e1 = -1; float v1 = -3.0e38f;
#pragma unroll
                for (int e = 0; e < 8; ++e) if (e != e0 && lg[e] > v1) { v1 = lg[e]; e1 = e; }
                const float g1 = 1.f / (1.f + expf(v0 - v1)), g0 = 1.f - g1;
                if (lane == 0) { TOKE[t] = (i32x2){e0, e1}; TOKG[t] = (f32x2){g0, g1}; __hip_atomic_fetch_add(lcnt + e0, 1, __ATOMIC_RELAXED, __HIP_MEMORY_SCOPE_WORKGROUP); __hip_atomic_fetch_add(lcnt + e1, 1, __ATOMIC_RELAXED, __HIP_MEMORY_SCOPE_WORKGROUP); }
            }
            __syncthreads();
            if (tid < 8) CNT[c * 8 + tid] = lcnt[tid];
        }
    }
    SEAM(15);
    if (IN(16)) {
        PH_BEGIN;
        LAS int* tab = (LAS int*)(F.lds + RING_OFF);
        LAS int* bse = tab + 2048;
        LAS int* sel = bse + 8;
        LAS int* dst = sel + 256;
        for (int c = blockIdx.x; c < 256; c += F.G) {
            __syncthreads();
            for (int i = tid; i < 2048; i += NWAVES * 64) tab[i] = CNT[i];
            if (tid < 128) { const i32x2 e = TOKE[c * 128 + tid]; sel[2 * tid] = e.x; sel[2 * tid + 1] = e.y; }
            __syncthreads();
            if (tid < 8) { const int e = tid; int pre = 0, tot = 0;
                for (int cc = 0; cc < 256; ++cc) { const int n = tab[cc * 8 + e]; tot += n; pre += (cc < c) ? n : 0; }
                bse[e] = pre; tab[e] = tot; }
            __syncthreads();
            if (tid < 8) { const int e = tid; int ps = 0;
                for (int k = 0; k < e; ++k) ps += (tab[k] + 255) & ~255;
                int r = ps + bse[e];
                for (int i = 0; i < 256; ++i) if (sel[i] == e) dst[i] = r++;
                if (c == 0) TOT[e] = tab[e]; }
            __syncthreads();
            if (tid < 128) TOKS[c * 128 + tid] = (i32x2){dst[2 * tid], dst[2 * tid + 1]};
            for (int i = wave; i < 128; i += NWAVES) {
                const int t = c * 128 + i; const int s0 = dst[2 * i], s1 = dst[2 * i + 1];
                const v4u* src = (const v4u*)(HFB + (size_t)t * DM) + lane; v4u* d0 = (v4u*)(XS + (size_t)s0 * DM) + lane; v4u* d1 = (v4u*)(XS + (size_t)s1 * DM) + lane;
#pragma unroll
                for (int j = 0; j < 4; ++j) { const v4u w = src[64 * j]; d0[64 * j] = w; d1[64 * j] = w; }
            }
        }
    }
    SEAM(16);
    {
        int cend[8]; int nMt = 0;
        if (IN(17) || IN(18) || IN(19) || IN(20)) {
            PH_BEGIN;
#pragma unroll
            for (int e = 0; e < 8; ++e) { nMt += (__builtin_amdgcn_readfirstlane(TOT[e]) + 255) >> 8; cend[e] = nMt; }
        }
#pragma unroll
        for (int rd = 0; rd < 2; ++rd) {
            const int t0 = rd * MOE_ROUND_TILES; int nt = nMt - t0; nt = nt > MOE_ROUND_TILES ? MOE_ROUND_TILES : nt; nt = nt < 0 ? 0 : nt;
            if (IN(17 + 2 * rd)) {
                PH_BEGIN;
                pg8::Gemm g{XS + (size_t)t0 * 256 * DM, W_GUE, nt * 256, 2 * FFE, DM}; pg8::MoeOrder S; S.init(nt * 256, 2 * FFE, F.G, (int)blockIdx.x); S.t0 = t0; S.estride = (size_t)2 * FFE * DM * 2;
#pragma unroll
                for (int e = 0; e < 8; ++e) S.cend[e] = cend[e];
                pg8::EpiSwiglu E{ACT, FFE};
                pg8::gemm_phase<pg8::EpiSwiglu, pg8::MoeOrder, true, true>(F.lds + RING_OFF, g, S, E);
            }
            SEAM(17 + 2 * rd);
            if (IN(18 + 2 * rd)) {
                PH_BEGIN;
                pg8::Gemm g{ACT, W_DE, nt * 256, DM, FFE}; pg8::MoeOrder S; S.init(nt * 256, DM, F.G, (int)blockIdx.x); S.t0 = t0; S.estride = (size_t)DM * FFE * 2;
#pragma unroll
                for (int e = 0; e < 8; ++e) S.cend[e] = cend[e];
                pg8::EpiBf16 E{Y + (size_t)t0 * 256 * DM, DM};
                pg8::gemm_phase<pg8::EpiBf16, pg8::MoeOrder, true, true>(F.lds + RING_OFF, g, S, E);
            }
            SEAM(18 + 2 * rd);
        }
    }
    if (IN(21)) {
        PH_BEGIN;
        for (int t = gw; t < T; t += NGW) {
            const i32x2 sl = TOKS[t]; const f32x2 gt = TOKG[t];
            f32x4* xr = (f32x4*)(outp + (size_t)t * DM) + 2 * lane; const v4u* y0 = (const v4u*)(Y + (size_t)sl.x * DM) + lane; const v4u* y1 = (const v4u*)(Y + (size_t)sl.y * DM) + lane;
#pragma unroll
            for (int j = 0; j < 4; ++j) { float a[8], b8[8]; unpack8(y0[64 * j], a); unpack8(y1[64 * j], b8);
                f32x4 x0 = xr[128 * j], x1 = xr[128 * j + 1];
                x0.x += gt.x * a[0] + gt.y * b8[0]; x0.y += gt.x * a[1] + gt.y * b8[1]; x0.z += gt.x * a[2] + gt.y * b8[2]; x0.w += gt.x * a[3] + gt.y * b8[3];
                x1.x += gt.x * a[4] + gt.y * b8[4]; x1.y += gt.x * a[5] + gt.y * b8[5]; x1.z += gt.x * a[6] + gt.y * b8[6]; x1.w += gt.x * a[7] + gt.y * b8[7];
                xr[128 * j] = x0; xr[128 * j + 1] = x1; }
        }
    }
#undef IN
#undef SEAM
#undef GRID_BAR
}

extern "C" void kernel_launch(void* const* d_in, const int* in_sizes, int n_in, void* d_out, int out_size, void* d_ws, size_t ws_size, hipStream_t stream) {
    static int grid = 0;
    if (grid == 0) {
        if (n_in != 27 || in_sizes[0] != T * DM || out_size != T * DM || ws_size < WS_END) { fprintf(stderr, "kernel_launch: shape/workspace mismatch: n_in %d in0 %d out %d ws %zu (need %zu)\n", n_in, n_in > 0 ? in_sizes[0] : -1, out_size, ws_size, (size_t)WS_END); grid = -1; return; }
        int dev = 0, cus = 0, per_cu = 0;
        if (hipGetDevice(&dev) != hipSuccess || hipDeviceGetAttribute(&cus, hipDeviceAttributeMultiprocessorCount, dev) != hipSuccess) { grid = -1; return; }
        if (hipFuncSetAttribute((const void*)mk_fwd, hipFuncAttributeMaxDynamicSharedMemorySize, LDS_BYTES) != hipSuccess) { fprintf(stderr, "kernel_launch: hipFuncSetAttribute failed\n"); grid = -1; return; }
        if (hipOccupancyMaxActiveBlocksPerMultiprocessor(&per_cu, (const void*)mk_fwd, NWAVES * 64, LDS_BYTES) != hipSuccess || per_cu < 1) { fprintf(stderr, "kernel_launch: occupancy query reports %d workgroups per CU\n", per_cu); }
        (void)hipGetLastError();
        grid = cus;
    }
    if (grid < 0) return;
    if (hipMemsetAsync((char*)d_ws + WS_CTL, 0, CTL_ZERO_BYTES, stream) != hipSuccess) return;
    Args a{};
    for (int i = 0; i < 27; ++i) a.in[i] = (const float*)d_in[i];
    a.out = (float*)d_out; a.ws = (unsigned char*)d_ws;
    for (int li = 0; li < N_LAUNCHES; ++li) {
        a.ph_lo = (N_LAUNCHES == 1) ? 0 : li; a.ph_hi = (N_LAUNCHES == 1) ? N_PHASES : li + 1;
        hipLaunchKernelGGL(mk_fwd, dim3(grid), dim3(NWAVES * 64), LDS_BYTES, stream, a);
        const hipError_t le = hipPeekAtLastError();
        if (le != hipSuccess) { fprintf(stderr, "kernel_launch: launch %d failed: %s\n", li, hipGetErrorName(le)); break; }
    }
}
```

```cpp
#include <hip/hip_runtime.h>
#include <cstdio>
#include <cstdint>
namespace pg8 {
#define PG8_LAS __attribute__((address_space(3)))
typedef unsigned short bf16_t;
typedef short bf16x8 __attribute__((ext_vector_type(8)));
typedef float f32x4 __attribute__((ext_vector_type(4)));
typedef unsigned u32x4 __attribute__((ext_vector_type(4)));
typedef int v4i32 __attribute__((ext_vector_type(4)));
typedef int v8i32 __attribute__((ext_vector_type(8)));
constexpr int BM = 256, BK = 64, HALF = 128, HTB = HALF * BK * 2  , STAGE_BYTES = 8 * HTB, NXCD = 8, WGM = 8;

__host__ __device__ __forceinline__ int lds_byte(int r, int c) { const int st = (r >> 4) * 2 + (c >> 5), rr = r & 15, cc = c & 31, ob = rr * 64 + cc * 2; return st * 1024 + (ob ^ (((ob >> 9) & 1) << 5)); }
__host__ __device__ __forceinline__ void stage_rc(int b, int& R, int& C) { const int st = b / 1024, sb = b % 1024, swz = sb ^ (((sb >> 9) & 1) << 5); R = (st >> 1) * 16 + swz / 64; C = (st & 1) * 32 + (swz % 64) / 2; }
__host__ __device__ __forceinline__ int perm32(int rho) { const int n = rho >> 4, i = rho & 15; return 8 * (i >> 2) + 4 * n + (i & 3); }

struct Unit { int pm, pn; };
struct Gemm { const bf16_t* A; const bf16_t* Bt; int M, N, K; };

struct StaticOrder {
    int nM, nN, nwg, G, c;
    __host__ __device__ void init(int M, int N, int G_, int c_) { nM = M / BM; nN = N / BM; nwg = nM * nN; G = G_; c = c_; }
    __host__ __device__ bool next(int i, Unit& u) const {
        const long L = (long)i * G + c; if (L >= nwg) return false;
        int wgid = (int)L; { const int q = nwg / NXCD, r = nwg % NXCD, xcd = wgid % NXCD, off = wgid / NXCD; wgid = (xcd < r ? xcd * (q + 1) : r * (q + 1) + (xcd - r) * q) + off; }
        const int nig = WGM * nN, gid = wgid / nig, fm = gid * WGM, gsz = (nM - fm) < WGM ? (nM - fm) : WGM;
        u.pm = fm + ((wgid % nig) % gsz); u.pn = (wgid % nig) / gsz; return true;
    }
    __device__ __forceinline__ void a_ready(const Unit&) const {}
    __device__ __forceinline__ void done(const Unit&) const {}
    __device__ __forceinline__ size_t b_extra(const Unit&) const { return 0; }
};
struct MoeOrder : StaticOrder {
    int t0; int cend[8]; size_t estride;
    __device__ __forceinline__ size_t b_extra(const Unit& u) const { const int pa = t0 + u.pm; int e = 0;
#pragma unroll
        for (int k = 0; k < 7; ++k) e += (pa >= cend[k]) ? 1 : 0;
        return (size_t)e * estride; }
};

__device__ __forceinline__ unsigned cvt_pk_bf16(float lo, float hi) { unsigned r; asm volatile("v_cvt_pk_bf16_f32 %0, %1, %2" : "=v"(r) : "v"(lo), "v"(hi)); return r; }

struct EpiBf16 {
    static constexpr bool PERM = true, AFTER_DRAIN = false;
    bf16_t* O; int ldc; float scale;
    __device__ __forceinline__ void operator()(const f32x4 (&acc)[2][2][4][2], const Unit& u, int wr, int wc, int fr, int fq) const {
        const int row0 = u.pm * BM + wr * 64 + fr; const int col0 = u.pn * BM + wc * 32 + 8 * fq;
#pragma unroll
        for (int ai = 0; ai < 2; ++ai)
#pragma unroll
            for (int m = 0; m < 4; ++m) { bf16_t* rowp = O + (size_t)(row0 + ai * HALF + m * 16) * ldc + col0;
#pragma unroll
                for (int bj = 0; bj < 2; ++bj) { const f32x4 v0 = acc[ai][bj][m][0] * scale, v1 = acc[ai][bj][m][1] * scale;
                    u32x4 w; w.x = cvt_pk_bf16(v0[0], v0[1]); w.y = cvt_pk_bf16(v0[2], v0[3]); w.z = cvt_pk_bf16(v1[0], v1[1]); w.w = cvt_pk_bf16(v1[2], v1[3]);
                    *(u32x4*)(rowp + bj * HALF) = w; } }
    }
};
__device__ __forceinline__ float silu_mul(float g, float u) { const float e = __builtin_amdgcn_exp2f(g * -1.4426950408889634f); return g * u * __builtin_amdgcn_rcpf(1.0f + e); }
__device__ __forceinline__ float silu_mul_raw(float ag, float au, float c1, float ic2) { const float e = __builtin_amdgcn_exp2f(ag * c1); return (ag * au) * __builtin_amdgcn_rcpf(__builtin_fmaf(e, ic2, ic2)); }
struct EpiSwiglu {
    static constexpr bool PERM = true, AFTER_DRAIN = false;
    bf16_t* O; int ldc; float sin;
    __device__ __forceinline__ void operator()(const f32x4 (&acc)[2][2][4][2], const Unit& u, int wr, int wc, int fr, int fq) const {
        const int row0 = u.pm * BM + wr * 64 + fr; const int col0 = u.pn * HALF + wc * 32 + 8 * fq; const float c1 = sin * -1.4426950408889634f, ic2 = 1.0f / (sin * sin);
#pragma unroll
        for (int ai = 0; ai < 2; ++ai)
#pragma unroll
            for (int m = 0; m < 4; ++m) { bf16_t* rowp = O + (size_t)(row0 + ai * HALF + m * 16) * ldc + col0;
                const f32x4 g0 = acc[ai][0][m][0], g1 = acc[ai][0][m][1], u0 = acc[ai][1][m][0], u1 = acc[ai][1][m][1];
#define SM_(g_, u_) silu_mul_raw(g_, u_, c1, ic2)
                u32x4 w; w.x = cvt_pk_bf16(SM_(g0[0], u0[0]), SM_(g0[1], u0[1])); w.y = cvt_pk_bf16(SM_(g0[2], u0[2]), SM_(g0[3], u0[3]));
                w.z = cvt_pk_bf16(SM_(g1[0], u1[0]), SM_(g1[1], u1[1])); w.w = cvt_pk_bf16(SM_(g1[2], u1[2]), SM_(g1[3], u1[3]));
#undef SM_
                *(u32x4*)rowp = w; }
    }
};
struct EpiRes {
    static constexpr bool PERM = false, AFTER_DRAIN = false;
    const float* base; float* out; int ldc;
    __device__ __forceinline__ void operator()(const f32x4 (&acc)[2][2][4][2], const Unit& u, int wr, int wc, int fr, int fq) const {
        const int col0 = u.pn * BM + wc * 32 + 4 * fq;
#pragma unroll
        for (int ai = 0; ai < 2; ++ai)
#pragma unroll
            for (int m = 0; m < 4; ++m) { const size_t off = (size_t)(u.pm * BM + ai * HALF + wr * 64 + m * 16 + fr) * ldc + col0;
#pragma unroll
                for (int bj = 0; bj < 2; ++bj)
#pragma unroll
                    for (int n = 0; n < 2; ++n) { const f32x4 bs = *(const f32x4*)(base + off + bj * HALF + n * 16); *(f32x4*)(out + off + bj * HALF + n * 16) = bs + acc[ai][bj][m][n]; }
                if (m & 1) asm volatile("" ::: "memory"); }
    }
};

struct EpiSwigluF8 {
    static constexpr bool PERM = true, AFTER_DRAIN = false;
    unsigned char* O; int ldc; float sin, sout;
    __device__ __forceinline__ void operator()(const f32x4 (&acc)[2][2][4][2], const Unit& u, int wr, int wc, int fr, int fq) const {
        const int row0 = u.pm * BM + wr * 64 + fr; const int col0 = u.pn * HALF + wc * 32 + 8 * fq; const float c1 = sin * -1.4426950408889634f, ic2 = 1.0f / (sin * sin * sout);
#pragma unroll
        for (int ai = 0; ai < 2; ++ai)
#pragma unroll
            for (int m = 0; m < 4; ++m) { unsigned char* rowp = O + (size_t)(row0 + ai * HALF + m * 16) * ldc + col0;
                const f32x4 g0 = acc[ai][0][m][0], g1 = acc[ai][0][m][1], u0 = acc[ai][1][m][0], u1 = acc[ai][1][m][1];
                unsigned w0 = 0u, w1 = 0u;
#define SM_(g_, u_) silu_mul_raw(g_, u_, c1, ic2)
                w0 = __builtin_amdgcn_cvt_pk_fp8_f32(SM_(g0[0], u0[0]), SM_(g0[1], u0[1]), w0, false); w0 = __builtin_amdgcn_cvt_pk_fp8_f32(SM_(g0[2], u0[2]), SM_(g0[3], u0[3]), w0, true);
                w1 = __builtin_amdgcn_cvt_pk_fp8_f32(SM_(g1[0], u1[0]), SM_(g1[1], u1[1]), w1, false); w1 = __builtin_amdgcn_cvt_pk_fp8_f32(SM_(g1[2], u1[2]), SM_(g1[3], u1[3]), w1, true);
#undef SM_
                typedef unsigned u32x2 __attribute__((ext_vector_type(2)));
                *(u32x2*)rowp = (u32x2){w0, w1}; }
    }
};

template <class Epi, class Sched, bool ALIGN_EPI = false, bool SP2 = false, bool F8 = false>
__device__ __forceinline__ void gemm_phase(PG8_LAS unsigned char* lds, const Gemm g, const Sched& S, const Epi& E) {
    int tid = threadIdx.x; asm volatile("" : "+v"(tid));
    const int wid = __builtin_amdgcn_readfirstlane(tid >> 6), lane = tid & 63, wr = wid >> 2, wc = wid & 3, fr = lane & 15, fq = lane >> 4;
    const int K = g.K, nt = K / BK;
    unsigned voffA[2], voffB[2];
#pragma unroll
    for (int i = 0; i < 2; ++i) { int R, C; stage_rc(tid * 16 + i * 8192, R, C); const int Rb = Epi::PERM ? ((R & ~31) + perm32(R & 31)) : R;
        voffA[i] = (unsigned)(R * K + C) * 2u; voffB[i] = (unsigned)(Rb * K + C) * 2u; }
    const size_t kstep = (size_t)(BK * 2);
    const size_t hstep = (size_t)HALF * K * 2;
    const size_t tstep = 2 * hstep;
    const unsigned ldsw = (unsigned)wid * 1024u;
    const int aoff = lds_byte(wr * 64 + fr, fq * 8), boff = lds_byte(wc * 32 + fr, fq * 8);
#define PG8_SA(b, h) (((b) * 2 + (h)) * HTB)
#define PG8_SB(b, h) ((4 + (b) * 2 + (h)) * HTB)
#define PG8_STAGE(bufoff, gbase, voff) do { _Pragma("unroll") for (int _i = 0; _i < 2; ++_i) \
        __builtin_amdgcn_global_load_lds((const unsigned*)((const char*)(gbase) + (voff)[_i]), (PG8_LAS unsigned*)(lds + (bufoff) + ldsw + _i * 8192), 16, 0, 0); } while (0)
#define PG8_LDA(dst, b, h) do { _Pragma("unroll") for (int m = 0; m < 4; ++m) _Pragma("unroll") for (int k = 0; k < 2; ++k) dst[m][k] = *(const PG8_LAS bf16x8*)(lds + PG8_SA(b, h) + aoff + m * 2048 + k * 1024); } while (0)
#define PG8_LDB(dst, b, h) do { _Pragma("unroll") for (int n = 0; n < 2; ++n) _Pragma("unroll") for (int k = 0; k < 2; ++k) dst[n][k] = *(const PG8_LAS bf16x8*)(lds + PG8_SB(b, h) + boff + n * 2048 + k * 1024); } while (0)
#define PG8_MMA(ai, bj, At, Bt) do { __builtin_amdgcn_s_setprio(1); \
        if constexpr (F8) { _Pragma("unroll") for (int m = 0; m < 4; ++m) _Pragma("unroll") for (int n = 0; n < 2; ++n) { \
            const v8i32 fb_ = __builtin_shufflevector(__builtin_bit_cast(v4i32, Bt[n][0]), __builtin_bit_cast(v4i32, Bt[n][1]), 0, 1, 2, 3, 4, 5, 6, 7); \
            const v8i32 fa_ = __builtin_shufflevector(__builtin_bit_cast(v4i32, At[m][0]), __builtin_bit_cast(v4i32, At[m][1]), 0, 1, 2, 3, 4, 5, 6, 7); \
            asm volatile("v_mfma_f32_16x16x128_f8f6f4 %0, %1, %2, %0" : "+v"(acc[ai][bj][m][n]) : "v"(fb_), "v"(fa_)); } } \
        else { _Pragma("unroll") for (int m = 0; m < 4; ++m) _Pragma("unroll") for (int n = 0; n < 2; ++n) _Pragma("unroll") for (int k = 0; k < 2; ++k) \
            acc[ai][bj][m][n] = __builtin_amdgcn_mfma_f32_16x16x32_bf16(Bt[n][k], At[m][k], acc[ai][bj][m][n], 0, 0, 0); } \
        __builtin_amdgcn_s_setprio(0); } while (0)
#define PG8_WAIT_V(n) asm volatile("s_waitcnt vmcnt(" #n ")" ::: "memory")
#define PG8_WAIT_L(n) asm volatile("s_waitcnt lgkmcnt(" #n ")" ::: "memory")
#define PG8_BAR __builtin_amdgcn_s_barrier()
#define PG8_SCHED __builtin_amdgcn_sched_barrier(0)
    Unit cur, nxt; int ui = 0;
    if (!S.next(0, cur)) return;
    f32x4 acc[2][2][4][2];
#pragma unroll
    for (int a = 0; a < 2; ++a)
#pragma unroll
        for (int b = 0; b < 2; ++b)
#pragma unroll
            for (int m = 0; m < 4; ++m)
#pragma unroll
                for (int n = 0; n < 2; ++n) acc[a][b][m][n] = (f32x4){0.f, 0.f, 0.f, 0.f};
    bf16x8 At[4][2], B0[2][2], B1[2][2];
    const char* cA = (const char*)g.A + (size_t)cur.pm * tstep; const char* cB = (const char*)g.Bt + S.b_extra(cur) + (size_t)cur.pn * tstep;
    S.a_ready(cur);
    if constexpr (SP2) {
        PG8_STAGE(PG8_SB(0, 0), cB, voffB); PG8_STAGE(PG8_SB(0, 1), cB + hstep, voffB); PG8_STAGE(PG8_SA(0, 0), cA, voffA); PG8_STAGE(PG8_SA(0, 1), cA + hstep, voffA);
        if (wr == 1) PG8_BAR;
        PG8_WAIT_V(2); PG8_BAR;
        PG8_STAGE(PG8_SB(1, 0), cB + kstep, voffB); PG8_STAGE(PG8_SA(1, 0), cA + kstep, voffA); PG8_STAGE(PG8_SB(1, 1), cB + hstep + kstep, voffB);
        PG8_WAIT_V(6); PG8_BAR;
    } else {
        PG8_STAGE(PG8_SB(0, 0), cB, voffB); PG8_STAGE(PG8_SA(0, 0), cA, voffA); PG8_STAGE(PG8_SB(0, 1), cB + hstep, voffB); PG8_STAGE(PG8_SA(0, 1), cA + hstep, voffA);
        if (wr == 1) PG8_BAR;
        PG8_WAIT_V(4); PG8_BAR;
        PG8_STAGE(PG8_SB(1, 0), cB + kstep, voffB); PG8_STAGE(PG8_SA(1, 0), cA + kstep, voffA); PG8_STAGE(PG8_SB(1, 1), cB + hstep + kstep, voffB);
        PG8_WAIT_V(6); PG8_BAR;
    }
    for (;;) {
        const bool has_next = S.next(ui + 1, nxt);
        const char* nA = has_next ? (const char*)g.A + (size_t)nxt.pm * tstep : cA; const char* nB = has_next ? (const char*)g.Bt + S.b_extra(nxt) + (size_t)nxt.pn * tstep : cB;
        for (int t = 0; t < nt; t += 2) {
            const bool last = (t == nt - 2);
            const char* a1 = cA + (size_t)(t + 1) * kstep;
            const char* a2 = last ? nA : cA + (size_t)(t + 2) * kstep; const char* b2 = last ? nB : cB + (size_t)(t + 2) * kstep;
            const char* a3 = a2 + kstep; const char* b3 = b2 + kstep;
            if (last && has_next) S.a_ready(nxt);
            if constexpr (SP2) {
            PG8_LDB(B0, 0, 0); PG8_LDB(B1, 0, 1); PG8_SCHED; PG8_LDA(At, 0, 0); PG8_STAGE(PG8_SA(1, 1), a1 + hstep, voffA);
            PG8_WAIT_V(8); PG8_WAIT_L(0); PG8_BAR; PG8_MMA(0, 0, At, B0); PG8_MMA(0, 1, At, B1); PG8_BAR; PG8_SCHED;
            PG8_LDA(At, 0, 1); PG8_STAGE(PG8_SB(0, 0), b2, voffB); PG8_STAGE(PG8_SB(0, 1), b2 + hstep, voffB); PG8_STAGE(PG8_SA(0, 0), a2, voffA);
            PG8_WAIT_V(8); PG8_WAIT_L(0); PG8_BAR; PG8_MMA(1, 0, At, B0); PG8_MMA(1, 1, At, B1); PG8_BAR; PG8_SCHED;
            PG8_LDB(B0, 1, 0); PG8_LDB(B1, 1, 1); PG8_SCHED; PG8_LDA(At, 1, 0); PG8_STAGE(PG8_SA(0, 1), a2 + hstep, voffA);
            PG8_WAIT_V(8); PG8_WAIT_L(0); PG8_BAR; PG8_MMA(0, 0, At, B0); PG8_MMA(0, 1, At, B1); PG8_BAR; PG8_SCHED;
            PG8_LDA(At, 1, 1); PG8_STAGE(PG8_SB(1, 0), b3, voffB); PG8_STAGE(PG8_SB(1, 1), b3 + hstep, voffB); PG8_STAGE(PG8_SA(1, 0), a3, voffA);
            PG8_WAIT_V(8); PG8_WAIT_L(0); PG8_BAR; PG8_MMA(1, 0, At, B0); PG8_MMA(1, 1, At, B1); PG8_BAR; PG8_SCHED;
            } else {
            PG8_LDB(B0, 0, 0); PG8_SCHED; PG8_LDA(At, 0, 0); PG8_STAGE(PG8_SA(1, 1), a1 + hstep, voffA);
            PG8_WAIT_L(8); PG8_BAR; PG8_WAIT_L(0); PG8_MMA(0, 0, At, B0); PG8_BAR; PG8_SCHED;
            PG8_LDB(B1, 0, 1); PG8_STAGE(PG8_SB(0, 0), b2, voffB);
            PG8_BAR; PG8_WAIT_L(0); PG8_MMA(0, 1, At, B1); PG8_BAR;
            PG8_LDA(At, 0, 1); PG8_STAGE(PG8_SA(0, 0), a2, voffA);
            PG8_BAR; PG8_WAIT_L(0); PG8_MMA(1, 0, At, B0); PG8_BAR; PG8_SCHED;
            PG8_STAGE(PG8_SB(0, 1), b2 + hstep, voffB);
            PG8_WAIT_V(6); PG8_BAR; PG8_MMA(1, 1, At, B1); PG8_BAR;
            PG8_LDB(B0, 1, 0); PG8_SCHED; PG8_LDA(At, 1, 0); PG8_STAGE(PG8_SA(0, 1), a2 + hstep, voffA);
            PG8_WAIT_L(8); PG8_BAR; PG8_WAIT_L(0); PG8_MMA(0, 0, At, B0); PG8_BAR; PG8_SCHED;
            PG8_LDB(B1, 1, 1); PG8_STAGE(PG8_SB(1, 0), b3, voffB);
            PG8_BAR; PG8_WAIT_L(0); PG8_MMA(0, 1, At, B1); PG8_BAR;
            PG8_LDA(At, 1, 1); PG8_STAGE(PG8_SA(1, 0), a3, voffA);
            PG8_BAR; PG8_WAIT_L(0); PG8_MMA(1, 0, At, B0); PG8_BAR; PG8_SCHED;
            PG8_STAGE(PG8_SB(1, 1), b3 + hstep, voffB);
            PG8_WAIT_V(6); PG8_BAR; PG8_MMA(1, 1, At, B1); PG8_BAR;
            }
        }
        if constexpr (ALIGN_EPI) { if (wr == 0) PG8_BAR; }
        if constexpr (F8) asm volatile("s_nop 15\n\ts_nop 15\n\ts_nop 15" ::: "memory");
        if constexpr (!Epi::AFTER_DRAIN) { E(acc, cur, wr, wc, fr, fq); S.done(cur); }
        if (!has_next) break;
#pragma unroll
        for (int a = 0; a < 2; ++a)
#pragma unroll
            for (int b = 0; b < 2; ++b)
#pragma unroll
                for (int m = 0; m < 4; ++m)
#pragma unroll
                    for (int n = 0; n < 2; ++n) acc[a][b][m][n] = (f32x4){0.f, 0.f, 0.f, 0.f};
        cur = nxt; cA = nA; cB = nB; ++ui;
        if constexpr (ALIGN_EPI) { if (wr == 1) PG8_BAR; }
    }
    PG8_WAIT_V(0);
    if constexpr (!ALIGN_EPI) { if (wr == 0) PG8_BAR; }
    PG8_BAR;
    if constexpr (Epi::AFTER_DRAIN) { E.fused(acc, cur, wr, wc, fr, fq, lds, wid, lane); S.done(cur); }
#undef PG8_SA
#undef PG8_SB
#undef PG8_STAGE
#undef PG8_LDA
#undef PG8_LDB
#undef PG8_MMA
#undef PG8_WAIT_V
#undef PG8_WAIT_L
#undef PG8_BAR
#undef PG8_SCHED
}
}
namespace att {
using bf16x8 = __attribute__((ext_vector_type(8))) short;
using s16x4  = __attribute__((ext_vector_type(4))) short;
using f32x16 = __attribute__((ext_vector_type(16))) float;
using u32x4  = __attribute__((ext_vector_type(4))) unsigned;
typedef unsigned short bf16;
constexpr int   D = 128, NW = 8, QBLK = 32, KVBLK = 64;
constexpr float SCALE = 0.088388347648318440f;
constexpr float THR = 8.f;
constexpr size_t SHM_V = KVBLK * D * 2, SHM_K = KVBLK * D * 2, SHM_ATTN = 2 * SHM_V + 2 * SHM_K + NW * 64 * 4;
#define KSWZ(row, colB) ((row) * 256 + ((colB) ^ (((row) & 7) << 4)))
#define SBAR() __builtin_amdgcn_sched_barrier(0)
__device__ __forceinline__ int crow(int r, int hi) { return (r & 3) + 8 * (r >> 2) + 4 * hi; }
__device__ __forceinline__ unsigned cvtpk(float lo, float hi) { unsigned r; asm volatile("v_cvt_pk_bf16_f32 %0, %1, %2" : "=v"(r) : "v"(lo), "v"(hi)); return r; }

__device__ __forceinline__ void partialSM(f32x16& p0, f32x16& p1, float& m_reg, float& mn, float& alpha, const float thr_raw = THR / SCALE, const float padd = 0.f) {
  constexpr float C = SCALE * 1.4426950408889634f;
  float pmax = p0[0];
#pragma unroll
  for (int r = 1; r < 16; ++r) pmax = fmaxf(pmax, p0[r]);
#pragma unroll
  for (int r = 0; r < 16; ++r) pmax = fmaxf(pmax, p1[r]);
  { auto rr = __builtin_amdgcn_permlane32_swap(__float_as_uint(pmax), __float_as_uint(pmax), false, false);
    pmax = fmaxf(__uint_as_float(rr[0]), __uint_as_float(rr[1])); }
  if (__builtin_expect(__all(pmax - m_reg <= thr_raw), 1)) { mn = m_reg; alpha = 1.f; }
  else { mn = fmaxf(m_reg, pmax); alpha = __builtin_amdgcn_exp2f((m_reg - mn) * C); m_reg = mn; }
  const float mnC = -mn * C + padd;
  { typedef float f32x2_ __attribute__((ext_vector_type(2))); const f32x2_ c2 = {C, C}, m2 = {mnC, mnC};
#pragma unroll
    for (int r = 0; r < 16; r += 2) { f32x2_ a = {p0[r], p0[r + 1]}, b = {p1[r], p1[r + 1]}; a = a * c2 + m2; b = b * c2 + m2; p0[r] = a.x; p0[r + 1] = a.y; p1[r] = b.x; p1[r + 1] = b.y; } }
#pragma unroll
  for (int r = 0; r < 16; ++r) p0[r] = __builtin_amdgcn_exp2f(p0[r]);
}
__device__ __forceinline__ void finishSM(f32x16& p0, f32x16& p1, float alpha, float& l_reg, bf16x8& pa0, bf16x8& pa1, bf16x8& pa2, bf16x8& pa3) {
#pragma unroll
  for (int r = 0; r < 16; ++r) p1[r] = __builtin_amdgcn_exp2f(p1[r]);
  float ps;
  { typedef float f32x2_ __attribute__((ext_vector_type(2))); f32x2_ a2 = {p0[0], p0[1]}, b2 = {p1[0], p1[1]};
#pragma unroll
    for (int r = 2; r < 16; r += 2) { a2 += (f32x2_){p0[r], p0[r + 1]}; b2 += (f32x2_){p1[r], p1[r + 1]}; }
    a2 += b2; ps = a2.x + a2.y; }
  { auto rr = __builtin_amdgcn_permlane32_swap(__float_as_uint(ps), __float_as_uint(ps), false, false);
    ps = __uint_as_float(rr[0]) + __uint_as_float(rr[1]); }
  l_reg = l_reg * alpha + ps;
#define PK4(P, BASE, OUT) do { unsigned a0 = cvtpk(P[BASE + 0], P[BASE + 1]), a1 = cvtpk(P[BASE + 2], P[BASE + 3]);   \
    unsigned b0 = cvtpk(P[BASE + 4], P[BASE + 5]), b1 = cvtpk(P[BASE + 6], P[BASE + 7]);                              \
    auto r0 = __builtin_amdgcn_permlane32_swap(a0, b0, false, false); auto r1 = __builtin_amdgcn_permlane32_swap(a1, b1, false, false); \
    u32x4 w = {r0[0], r1[0], r0[1], r1[1]}; OUT = *reinterpret_cast<bf16x8*>(&w); } while (0)
  PK4(p0, 0, pa0); PK4(p0, 8, pa1); PK4(p1, 0, pa2); PK4(p1, 8, pa3);
#undef PK4
}
template <int MODE>
__device__ __forceinline__ void qkt(f32x16& p0, f32x16& p1, const char* Ks, const bf16x8* qr, int r32, int hi, float dq, float slopeS) {
  if constexpr (MODE == 0) { p0 = f32x16{}; p1 = f32x16{}; }
  else {
#pragma unroll
    for (int r = 0; r < 16; ++r) { const float d0 = dq - (float)((r & 3) + 8 * (r >> 2)), d1 = d0 - 32.f;
      p0[r] = __builtin_fabsf(d0) * -slopeS; p1[r] = __builtin_fabsf(d1) * -slopeS;
      if constexpr (MODE == 2) { if (__builtin_fabsf(d0) > 64.f) p0[r] = -__builtin_inff(); if (__builtin_fabsf(d1) > 64.f) p1[r] = -__builtin_inff(); } }
  }
#pragma unroll
  for (int d0 = 0; d0 < 8; ++d0) { const int cb = (d0 * 16 + hi * 8) * 2;
    bf16x8 b0 = *reinterpret_cast<const bf16x8*>(Ks + KSWZ(r32, cb));
    bf16x8 b1 = *reinterpret_cast<const bf16x8*>(Ks + KSWZ(32 + r32, cb));
    p0 = __builtin_amdgcn_mfma_f32_32x32x16_bf16(b0, qr[d0], p0, 0, 0, 0);
    p1 = __builtin_amdgcn_mfma_f32_32x32x16_bf16(b1, qr[d0], p1, 0, 0, 0); }
}
typedef int v4i32 __attribute__((ext_vector_type(4)));
typedef int v8i32 __attribute__((ext_vector_type(8)));
#define K8OFF(row, c) ((row) * 128 + ((((c)) ^ (((row) >> 1) & 7)) << 4))
__device__ __forceinline__ int k8off(int row, int c) { return K8OFF(row, c); }
__device__ __forceinline__ unsigned pk4f8(float a, float b, float c, float d) { unsigned w = 0u; w = __builtin_amdgcn_cvt_pk_fp8_f32(a, b, w, false); w = __builtin_amdgcn_cvt_pk_fp8_f32(c, d, w, true); return w; }
__device__ __forceinline__ float bfl(unsigned w) { return __uint_as_float(w << 16); }
__device__ __forceinline__ float bfh(unsigned w) { return __uint_as_float(w & 0xffff0000u); }
__device__ __forceinline__ void bf8_to_f8(const bf16x8 x, unsigned& lo, unsigned& hi) {
  const u32x4 w = __builtin_bit_cast(u32x4, x); lo = pk4f8(bfl(w.x), bfh(w.x), bfl(w.y), bfh(w.y)); hi = pk4f8(bfl(w.z), bfh(w.z), bfl(w.w), bfh(w.w)); }
template <int MODE>
__device__ __forceinline__ void qkt8(f32x16& p0, f32x16& p1, const char* Ks, const v8i32* q8, int r32, int hi, float dq, float slopeS) {
  if constexpr (MODE == 0) { p0 = f32x16{}; p1 = f32x16{}; }
  else {
#pragma unroll
    for (int r = 0; r < 16; ++r) { const float d0 = dq - (float)((r & 3) + 8 * (r >> 2)), d1 = d0 - 32.f;
      p0[r] = __builtin_fabsf(d0) * -slopeS; p1[r] = __builtin_fabsf(d1) * -slopeS;
      if constexpr (MODE == 2) { if (__builtin_fabsf(d0) > 64.f) p0[r] = -__builtin_inff(); if (__builtin_fabsf(d1) > 64.f) p1[r] = -__builtin_inff(); } }
  }
#pragma unroll
  for (int m = 0; m < 2; ++m) { const int c0 = 4 * m + 2 * hi;
    const v4i32 a0l = *reinterpret_cast<const v4i32*>(Ks + K8OFF(r32, c0)), a0h = *reinterpret_cast<const v4i32*>(Ks + K8OFF(r32, c0 + 1));
    const v4i32 a1l = *reinterpret_cast<const v4i32*>(Ks + K8OFF(32 + r32, c0)), a1h = *reinterpret_cast<const v4i32*>(Ks + K8OFF(32 + r32, c0 + 1));
    const v8i32 a0 = __builtin_shufflevector(a0l, a0h, 0, 1, 2, 3, 4, 5, 6, 7), a1 = __builtin_shufflevector(a1l, a1h, 0, 1, 2, 3, 4, 5, 6, 7);
    p0 = __builtin_amdgcn_mfma_scale_f32_32x32x64_f8f6f4(a0, q8[m], p0, 0, 0, 0, 0, 0, 0);
    p1 = __builtin_amdgcn_mfma_scale_f32_32x32x64_f8f6f4(a1, q8[m], p1, 0, 0, 0, 0, 0, 0); }
}
__device__ __forceinline__ int v_st(int k, int c) { const int kk = (k & ~0xC) | ((k & 4) << 1) | ((k & 8) >> 1); return ((kk >> 3) * 4 + (c >> 5)) * 512 + ((kk & 7) * 32 + (c & 31)) * 2; }
__device__ __forceinline__ int v_rd_base(int lane) { return ((lane & 3) << 3) | (((lane >> 2) & 3) << 6) | (((lane >> 4) & 1) << 5) | (((lane >> 5) & 1) << 8); }
constexpr int v_rd_off(int d0, int ks, int half) { return d0 * 512 + ks * 4096 + half * 2048; }
template <int OFF> __device__ __forceinline__ s16x4 tr_read(int vb) {
  s16x4 r; asm volatile("ds_read_b64_tr_b16 %0, %1 offset:%2" : "=&v"(r) : "v"(vb), "i"(OFF) : "memory"); return r;
}
template <int D0> __device__ __forceinline__ void pv_one(f32x16& od, int vb, bf16x8 pa0, bf16x8 pa1, bf16x8 pa2, bf16x8 pa3) {
  const s16x4 l0 = tr_read<v_rd_off(D0, 0, 0)>(vb), h0 = tr_read<v_rd_off(D0, 0, 1)>(vb), l1 = tr_read<v_rd_off(D0, 1, 0)>(vb), h1 = tr_read<v_rd_off(D0, 1, 1)>(vb);
  const s16x4 l2 = tr_read<v_rd_off(D0, 2, 0)>(vb), h2 = tr_read<v_rd_off(D0, 2, 1)>(vb), l3 = tr_read<v_rd_off(D0, 3, 0)>(vb), h3 = tr_read<v_rd_off(D0, 3, 1)>(vb);
  asm volatile("s_waitcnt lgkmcnt(0)" ::: "memory"); SBAR();
#define PK(L, H) (bf16x8){L[0], L[1], L[2], L[3], H[0], H[1], H[2], H[3]}
  od = __builtin_amdgcn_mfma_f32_32x32x16_bf16(pa0, PK(l0, h0), od, 0, 0, 0);
  od = __builtin_amdgcn_mfma_f32_32x32x16_bf16(pa1, PK(l1, h1), od, 0, 0, 0);
  od = __builtin_amdgcn_mfma_f32_32x32x16_bf16(pa2, PK(l2, h2), od, 0, 0, 0);
  od = __builtin_amdgcn_mfma_f32_32x32x16_bf16(pa3, PK(l3, h3), od, 0, 0, 0);
#undef PK
}
__device__ __forceinline__ void pv_d0(f32x16* o, int vb, bf16x8 pa0, bf16x8 pa1, bf16x8 pa2, bf16x8 pa3) {
  pv_one<0>(o[0], vb, pa0, pa1, pa2, pa3); pv_one<1>(o[1], vb, pa0, pa1, pa2, pa3); pv_one<2>(o[2], vb, pa0, pa1, pa2, pa3); pv_one<3>(o[3], vb, pa0, pa1, pa2, pa3);
}

template <int MODE, int SD, int QK8 = 0>
__device__ __forceinline__ void attn_unit(const bf16* __restrict__ Qb, int ldq, const bf16* __restrict__ Kh, const bf16* __restrict__ Vh, int ldk,
                                          bf16* __restrict__ Ob, int ldo_, float* __restrict__ lse_out, int lse_stride_, int NT, float dq0, float slopeS, char* lds) {
  constexpr bool NOPV = (MODE == 3);
  int tid = threadIdx.x; asm volatile("" : "+v"(tid));
  const int wid = __builtin_amdgcn_readfirstlane(tid >> 6), lane = tid & 63, r32 = lane & 31, hi = lane >> 5;
  char* V_lds = lds; char* K_lds = lds + 2 * SHM_V;
  float* ws = (float*)(lds + 2 * SHM_V + 2 * SHM_K) + wid * 64; float* li_l = ws; float* al_l = ws + 32;
  float m_reg = -1e30f, l_reg = 0; f32x16 o[4] = {}; bf16x8 qr[8];
  const bf16* Qw = Qb + (unsigned)((wid * QBLK + r32) * ldq + hi * 8);
  v8i32 q8[2];
  if constexpr (QK8) {
    const bf16* Q8 = Qb + (unsigned)((wid * QBLK + r32) * ldq + hi * 32);
#pragma unroll
    for (int m = 0; m < 2; ++m) { unsigned w[8];
#pragma unroll
      for (int c = 0; c < 4; ++c) bf8_to_f8(*reinterpret_cast<const bf16x8*>(Q8 + m * 64 + c * 8), w[2 * c], w[2 * c + 1]);
      q8[m] = (v8i32){(int)w[0], (int)w[1], (int)w[2], (int)w[3], (int)w[4], (int)w[5], (int)w[6], (int)w[7]}; }
  } else {
#pragma unroll
    for (int d0 = 0; d0 < 8; ++d0) qr[d0] = *reinterpret_cast<const bf16x8*>(Qw + d0 * 16);
  }
  const int sr = tid >> 4, sc = (tid & 15) * 8, vst0 = v_st(sr, sc), vst1 = v_st(32 + sr, sc);
  const int vb0 = (int)(uintptr_t)V_lds + v_rd_base(lane);
  const float dqb = dq0 + (float)(wid * QBLK + r32 - 4 * hi);
  struct { bf16x8 vs0, vs1, ks0, ks1; } sr_[SD];
#define SLOAD(i, k0) do { if constexpr (!NOPV) { sr_[i].vs0 = *reinterpret_cast<const bf16x8*>(&Vh[(unsigned)(((k0) + sr) * ldk + sc)]); sr_[i].vs1 = *reinterpret_cast<const bf16x8*>(&Vh[(unsigned)(((k0) + 32 + sr) * ldk + sc)]); } \
    sr_[i].ks0 = *reinterpret_cast<const bf16x8*>(&Kh[(unsigned)(((k0) + sr) * ldk + sc)]); sr_[i].ks1 = *reinterpret_cast<const bf16x8*>(&Kh[(unsigned)(((k0) + 32 + sr) * ldk + sc)]); } while (0)
#define SWRITE(b, i) do { if constexpr (!NOPV) { *(bf16x8*)(V_lds + (b) * SHM_V + vst0) = sr_[i].vs0;          \
    *(bf16x8*)(V_lds + (b) * SHM_V + vst1) = sr_[i].vs1; } const int kc = sc * 2;               \
    if constexpr (QK8) { typedef unsigned u32x2_ __attribute__((ext_vector_type(2))); unsigned l0_, h0_, l1_, h1_; bf8_to_f8(sr_[i].ks0, l0_, h0_); bf8_to_f8(sr_[i].ks1, l1_, h1_); \
      *(u32x2_*)(K_lds + (b) * SHM_K + K8OFF(sr, sc >> 4) + ((sc >> 3) & 1) * 8) = (u32x2_){l0_, h0_}; *(u32x2_*)(K_lds + (b) * SHM_K + K8OFF(32 + sr, sc >> 4) + ((sc >> 3) & 1) * 8) = (u32x2_){l1_, h1_}; } \
    else { *(bf16x8*)(K_lds + (b) * SHM_K + KSWZ(sr, kc)) = sr_[i].ks0;                       \
    *(bf16x8*)(K_lds + (b) * SHM_K + KSWZ(32 + sr, kc)) = sr_[i].ks1; } } while (0)
#define QKT(P0_, P1_, KS_, DQ_) do { if constexpr (QK8) qkt8<MODE>(P0_, P1_, KS_, q8, r32, hi, DQ_, slopeS); else qkt<MODE>(P0_, P1_, KS_, qr, r32, hi, DQ_, slopeS); } while (0)
#define SWAIT() do { if constexpr (SD == 2 && !NOPV) asm volatile("s_waitcnt vmcnt(4)" ::: "memory"); else if constexpr (SD == 2) asm volatile("s_waitcnt vmcnt(2)" ::: "memory"); else asm volatile("s_waitcnt vmcnt(0)" ::: "memory"); } while (0)
#define RESC(a) do { if constexpr (!NOPV) if (__any((a) < 1.f)) { if (hi == 0) al_l[r32] = (a); asm volatile("s_waitcnt lgkmcnt(0)" ::: "memory"); \
    _Pragma("unroll") for (int d = 0; d < 4; ++d) _Pragma("unroll") for (int r = 0; r < 16; ++r) o[d][r] *= al_l[crow(r, hi)]; } } while (0)
  f32x16 pA0, pA1, pB0, pB1; float mnA, mnB, alA, alB; bf16x8 pa0, pa1, pa2, pa3;
  constexpr int SE = 0, SO = SD - 1;
  SLOAD(SE, 0); asm volatile("s_waitcnt vmcnt(0)" ::: "memory"); SWRITE(0, SE); __syncthreads();
  QKT(pA0, pA1, K_lds, dqb); partialSM(pA0, pA1, m_reg, mnA, alA);
  SLOAD(SO, KVBLK); if constexpr (SD == 2) { if (2 < NT) SLOAD(SE, 2 * KVBLK); }
  SWAIT(); SWRITE(1, SO); __syncthreads();
  for (int j = 1; j + 1 < NT; j += 2) {
    SBAR(); QKT(pB0, pB1, K_lds + SHM_K, dqb - (float)(j * KVBLK));
    finishSM(pA0, pA1, alA, l_reg, pa0, pa1, pa2, pa3); SBAR();
    SLOAD(SO, (j + SD) * KVBLK); SBAR();
    if constexpr (!NOPV) pv_d0(o, vb0, pa0, pa1, pa2, pa3); partialSM(pB0, pB1, m_reg, mnB, alB);
    __syncthreads(); SWAIT(); SWRITE(0, SE);
    RESC(alB); __syncthreads();
    SBAR(); QKT(pA0, pA1, K_lds, dqb - (float)((j + 1) * KVBLK));
    finishSM(pB0, pB1, alB, l_reg, pa0, pa1, pa2, pa3); SBAR();
    if (SD == 1 || j + 3 < NT) SLOAD(SE, (j + 1 + SD) * KVBLK); SBAR();
    if constexpr (!NOPV) pv_d0(o, vb0 + (int)SHM_V, pa0, pa1, pa2, pa3); partialSM(pA0, pA1, m_reg, mnA, alA);
    __syncthreads(); SWAIT(); SWRITE(1, SO);
    RESC(alA); __syncthreads();
  }
  SBAR(); QKT(pB0, pB1, K_lds + SHM_K, dqb - (float)((NT - 1) * KVBLK));
  finishSM(pA0, pA1, alA, l_reg, pa0, pa1, pa2, pa3); SBAR();
  if constexpr (!NOPV) pv_d0(o, vb0, pa0, pa1, pa2, pa3); partialSM(pB0, pB1, m_reg, mnB, alB);
  __syncthreads(); RESC(alB);
  finishSM(pB0, pB1, alB, l_reg, pa0, pa1, pa2, pa3); SBAR();
  if constexpr (!NOPV) pv_d0(o, vb0 + (int)SHM_V, pa0, pa1, pa2, pa3);
  if constexpr (!NOPV) {
  if (hi == 0) li_l[r32] = l_reg; asm volatile("s_waitcnt lgkmcnt(0)" ::: "memory");
  float rli[16];
#pragma unroll
  for (int r = 0; r < 16; ++r) rli[r] = __builtin_amdgcn_rcpf(li_l[crow(r, hi)]);
  int ldo = ldo_; asm volatile("" : "+s"(ldo));
  bf16* Ow = Ob + (unsigned)((wid * QBLK) * ldo);
#pragma unroll
  for (int r = 0; r < 16; ++r) { const int orow = crow(r, hi);
#pragma unroll
    for (int d0 = 0; d0 < 4; ++d0) { const float v = o[d0][r] * rli[r]; unsigned u = __builtin_bit_cast(unsigned, v); u = (u + 0x7fffu + ((u >> 16) & 1u)) >> 16; Ow[(unsigned)(orow * ldo + d0 * 32 + r32)] = (bf16)u; } }
  }
  if constexpr (MODE == 2 || MODE == 3) { int lse_stride = lse_stride_; asm volatile("" : "+s"(lse_stride)); if (hi == 0) lse_out[(unsigned)((wid * QBLK + r32) * lse_stride)] = m_reg * SCALE + __logf(l_reg); }
#undef QKT
#undef SLOAD
#undef SWRITE
#undef SWAIT
#undef RESC
}

__device__ __forceinline__ bf16x8 round_f8(const bf16x8 x, float& n2) {
  typedef float f32x2_ __attribute__((ext_vector_type(2)));
  unsigned lo, hi; bf8_to_f8(x, lo, hi);
  const f32x2_ a = __builtin_amdgcn_cvt_pk_f32_fp8((int)lo, false), b = __builtin_amdgcn_cvt_pk_f32_fp8((int)lo, true), c = __builtin_amdgcn_cvt_pk_f32_fp8((int)hi, false), d = __builtin_amdgcn_cvt_pk_f32_fp8((int)hi, true);
  n2 += a.x * a.x + a.y * a.y + b.x * b.x + b.y * b.y + c.x * c.x + c.y * c.y + d.x * d.x + d.y * d.y;
  const u32x4 w = {(__float_as_uint(a.x) >> 16) | (__float_as_uint(a.y) & 0xffff0000u), (__float_as_uint(b.x) >> 16) | (__float_as_uint(b.y) & 0xffff0000u),
                   (__float_as_uint(c.x) >> 16) | (__float_as_uint(c.y) & 0xffff0000u), (__float_as_uint(d.x) >> 16) | (__float_as_uint(d.y) & 0xffff0000u)};
  return __builtin_bit_cast(bf16x8, w);
}
__device__ __forceinline__ float lse_block(const bf16x8 (&ks)[8], const bf16x8 (&qr)[8], float slopeS, char* lds) {
  int tid = threadIdx.x; asm volatile("" : "+v"(tid));
  const int wid = __builtin_amdgcn_readfirstlane(tid >> 6), lane = tid & 63, r32 = lane & 31, hi = lane >> 5;
  const int sr = tid >> 4, kc = (tid & 15) * 16;
#pragma unroll
  for (int i = 0; i < 8; ++i) *(bf16x8*)(lds + (i >> 1) * SHM_K + KSWZ((i & 1) * 32 + sr, kc)) = ks[i];
  __syncthreads();
  const float dqb = (float)(wid * QBLK + r32 - 4 * hi);
  float m_reg = -1e30f, l_reg = 0.f;
#pragma unroll 1
  for (int t = 0; t < 4; ++t) {
    f32x16 p0, p1; float mn, al;
    qkt<1>(p0, p1, lds + t * SHM_K, qr, r32, hi, dqb - (float)(t * KVBLK), slopeS);
    partialSM(p0, p1, m_reg, mn, al);
    float ps = 0.f;
#pragma unroll
    for (int r = 0; r < 16; ++r) ps += p0[r] + __builtin_amdgcn_exp2f(p1[r]);
    { auto rr = __builtin_amdgcn_permlane32_swap(__float_as_uint(ps), __float_as_uint(ps), false, false);
      ps = __uint_as_float(rr[0]) + __uint_as_float(rr[1]); }
    l_reg = l_reg * al + ps;
  }
  return m_reg * SCALE + __logf(l_reg);
}

constexpr float THR8 = 3.0f, PSC = 16.f, PSC_LOG2 = 4.f;
__device__ __forceinline__ void finishSM8(f32x16& p0, f32x16& p1, float alpha, float& l_reg, v8i32& pa) {
#pragma unroll
  for (int r = 0; r < 16; ++r) p1[r] = __builtin_amdgcn_exp2f(p1[r]);
  float ps;
  { typedef float f32x2_ __attribute__((ext_vector_type(2))); f32x2_ a2 = {p0[0], p0[1]}, b2 = {p1[0], p1[1]};
#pragma unroll
    for (int r = 2; r < 16; r += 2) { a2 += (f32x2_){p0[r], p0[r + 1]}; b2 += (f32x2_){p1[r], p1[r + 1]}; }
    a2 += b2; ps = a2.x + a2.y; }
  { auto rr = __builtin_amdgcn_permlane32_swap(__float_as_uint(ps), __float_as_uint(ps), false, false);
    ps = __uint_as_float(rr[0]) + __uint_as_float(rr[1]); }
  l_reg = l_reg * alpha + ps;
  unsigned w[8];
#pragma unroll
  for (int g = 0; g < 4; ++g) { w[g] = pk4f8(p0[4 * g], p0[4 * g + 1], p0[4 * g + 2], p0[4 * g + 3]); w[4 + g] = pk4f8(p1[4 * g], p1[4 * g + 1], p1[4 * g + 2], p1[4 * g + 3]); }
  pa = (v8i32){(int)w[0], (int)w[1], (int)w[2], (int)w[3], (int)w[4], (int)w[5], (int)w[6], (int)w[7]};
}
__device__ __forceinline__ void pv8(f32x16* o, const char* Vs, const v8i32 pa, int r32, int hi) {
  const int sw = (r32 >> 2) & 3;
#pragma unroll
  for (int d0 = 0; d0 < 4; ++d0) { const char* p = Vs + (32 * d0 + r32) * 64;
    const v4i32 lo = *reinterpret_cast<const v4i32*>(p + (((2 * hi) ^ sw) << 4)), hh = *reinterpret_cast<const v4i32*>(p + (((2 * hi + 1) ^ sw) << 4));
    const v8i32 f = __builtin_shufflevector(lo, hh, 0, 1, 2, 3, 4, 5, 6, 7);
    o[d0] = __builtin_amdgcn_mfma_scale_f32_32x32x64_f8f6f4(pa, f, o[d0], 0, 0, 0, 0, 0, 0); }
}
template <int MODE, int SD, bool KIMG = false>
__device__ __forceinline__ void attn_unit_f8(const bf16* __restrict__ Qb, int ldq, const bf16* __restrict__ Kh, int ldk, const unsigned char* __restrict__ V8,
                                             bf16* __restrict__ Ob, int ldo_, int NT, int t0, float dq0, float slopeS, char* lds) {
  int tid = threadIdx.x; asm volatile("" : "+v"(tid));
  const int wid = __builtin_amdgcn_readfirstlane(tid >> 6), lane = tid & 63, r32 = lane & 31, hi = lane >> 5;
  char* V_lds = lds; char* K_lds = lds + 2 * SHM_V;
  float* ws = (float*)(lds + 2 * SHM_V + 2 * SHM_K) + wid * 64; float* li_l = ws; float* al_l = ws + 32;
  float m_reg = -1e30f, l_reg = 0; f32x16 o[4] = {};
  v8i32 q8[2];
  { const bf16* Q8 = Qb + (unsigned)((wid * QBLK + r32) * ldq + hi * 32);
#pragma unroll
    for (int m = 0; m < 2; ++m) { unsigned w[8];
#pragma unroll
      for (int c = 0; c < 4; ++c) bf8_to_f8(*reinterpret_cast<const bf16x8*>(Q8 + m * 64 + c * 8), w[2 * c], w[2 * c + 1]);
      q8[m] = (v8i32){(int)w[0], (int)w[1], (int)w[2], (int)w[3], (int)w[4], (int)w[5], (int)w[6], (int)w[7]}; } }
  const int sr = tid >> 4, sc = (tid & 15) * 8;
  const float dqb = dq0 + (float)(wid * QBLK + r32 - 4 * hi);
  struct { bf16x8 ks0, ks1; u32x4 v; } sr_[SD];
#define SLOAD(i, t_) do { const unsigned io_ = (unsigned)((t0 + (t_)) * 8192 + tid * 16); sr_[i].v = *reinterpret_cast<const u32x4*>(V8 + io_); \
    if constexpr (KIMG) sr_[i].ks0 = *reinterpret_cast<const bf16x8*>((const unsigned char*)Kh + io_); \
    else { sr_[i].ks0 = *reinterpret_cast<const bf16x8*>(&Kh[(unsigned)(((t_) * KVBLK + sr) * ldk + sc)]); sr_[i].ks1 = *reinterpret_cast<const bf16x8*>(&Kh[(unsigned)(((t_) * KVBLK + 32 + sr) * ldk + sc)]); } } while (0)
#define SWRITE(b, i) do { *(u32x4*)(V_lds + (b) * SHM_V + tid * 16) = sr_[i].v; \
    if constexpr (KIMG) *(bf16x8*)(K_lds + (b) * SHM_K + tid * 16) = sr_[i].ks0; \
    else { typedef unsigned u32x2_ __attribute__((ext_vector_type(2))); unsigned l0_, h0_, l1_, h1_; bf8_to_f8(sr_[i].ks0, l0_, h0_); bf8_to_f8(sr_[i].ks1, l1_, h1_); \
    *(u32x2_*)(K_lds + (b) * SHM_K + K8OFF(sr, sc >> 4) + ((sc >> 3) & 1) * 8) = (u32x2_){l0_, h0_}; *(u32x2_*)(K_lds + (b) * SHM_K + K8OFF(32 + sr, sc >> 4) + ((sc >> 3) & 1) * 8) = (u32x2_){l1_, h1_}; } } while (0)
#define SWAIT() do { if constexpr (SD == 2) asm volatile("s_waitcnt vmcnt(%0)" :: "n"(KIMG ? 2 : 3) : "memory"); else asm volatile("s_waitcnt vmcnt(0)" ::: "memory"); } while (0)
#define RESC(a) do { if (__any((a) < 1.f)) { if (hi == 0) al_l[r32] = (a); asm volatile("s_waitcnt lgkmcnt(0)" ::: "memory"); \
    _Pragma("unroll") for (int d = 0; d < 4; ++d) _Pragma("unroll") for (int r = 0; r < 16; ++r) o[d][r] *= al_l[crow(r, hi)]; } } while (0)
  f32x16 pA0, pA1, pB0, pB1; float mnA, mnB, alA, alB; v8i32 pa;
  constexpr int SE = 0, SO = SD - 1; constexpr float TR = THR8 / SCALE;
  SLOAD(SE, 0); asm volatile("s_waitcnt vmcnt(0)" ::: "memory"); SWRITE(0, SE); __syncthreads();
  qkt8<MODE>(pA0, pA1, K_lds, q8, r32, hi, dqb, slopeS); partialSM(pA0, pA1, m_reg, mnA, alA, TR, PSC_LOG2);
  SLOAD(SO, 1); if constexpr (SD == 2) { if (2 < NT) SLOAD(SE, 2); }
  SWAIT(); SWRITE(1, SO); __syncthreads();
  for (int j = 1; j + 1 < NT; j += 2) {
    SBAR(); qkt8<MODE>(pB0, pB1, K_lds + SHM_K, q8, r32, hi, dqb - (float)(j * KVBLK), slopeS);
    finishSM8(pA0, pA1, alA, l_reg, pa); SBAR();
    SLOAD(SO, j + SD); SBAR();
    pv8(o, V_lds, pa, r32, hi); partialSM(pB0, pB1, m_reg, mnB, alB, TR, PSC_LOG2);
    __syncthreads(); SWAIT(); SWRITE(0, SE);
    RESC(alB); __syncthreads();
    SBAR(); qkt8<MODE>(pA0, pA1, K_lds, q8, r32, hi, dqb - (float)((j + 1) * KVBLK), slopeS);
    finishSM8(pB0, pB1, alB, l_reg, pa); SBAR();
    if (SD == 1 || j + 3 < NT) SLOAD(SE, j + 1 + SD); SBAR();
    pv8(o, V_lds + SHM_V, pa, r32, hi); partialSM(pA0, pA1, m_reg, mnA, alA, TR, PSC_LOG2);
    __syncthreads(); SWAIT(); SWRITE(1, SO);
    RESC(alA); __syncthreads();
  }
  SBAR(); qkt8<MODE>(pB0, pB1, K_lds + SHM_K, q8, r32, hi, dqb - (float)((NT - 1) * KVBLK), slopeS);
  finishSM8(pA0, pA1, alA, l_reg, pa); SBAR();
  pv8(o, V_lds, pa, r32, hi); partialSM(pB0, pB1, m_reg, mnB, alB, TR, PSC_LOG2);
  __syncthreads(); RESC(alB);
  finishSM8(pB0, pB1, alB, l_reg, pa); SBAR();
  pv8(o, V_lds + SHM_V, pa, r32, hi);
  if (hi == 0) li_l[r32] = l_reg; asm volatile("s_waitcnt lgkmcnt(0)" ::: "memory");
  float rli[16];
#pragma unroll
  for (int r = 0; r < 16; ++r) rli[r] = __builtin_amdgcn_rcpf(li_l[crow(r, hi)]);
  int ldo = ldo_; asm volatile("" : "+s"(ldo));
  bf16* Ow = Ob + (unsigned)((wid * QBLK) * ldo);
#pragma unroll
  for (int r = 0; r < 16; ++r) { const int orow = crow(r, hi);
#pragma unroll
    for (int d0 = 0; d0 < 4; ++d0) { const float v = o[d0][r] * rli[r]; unsigned u = __builtin_bit_cast(unsigned, v); u = (u + 0x7fffu + ((u >> 16) & 1u)) >> 16; Ow[(unsigned)(orow * ldo + d0 * 32 + r32)] = (bf16)u; } }
#undef SLOAD
#undef SWRITE
#undef SWAIT
#undef RESC
}
template <int MODE, int SD, bool KIMG = false>
__device__ __forceinline__ void attn_unit_f8_dv2(const bf16* __restrict__ Qb, int ldq, const bf16* __restrict__ Kh, int ldk, const unsigned char* __restrict__ V8a, const unsigned char* __restrict__ V8b,
                                                 bf16* __restrict__ Ob, int ldo_, int NT, int t0, float dq0, float slopeS, char* lds) {
  int tid = threadIdx.x; asm volatile("" : "+v"(tid));
  const int wid = __builtin_amdgcn_readfirstlane(tid >> 6), lane = tid & 63, r32 = lane & 31, hi = lane >> 5;
  char* V_lds = lds; char* K_lds = lds + 2 * SHM_V;
  float* ws = (float*)(lds + 2 * SHM_V + 2 * SHM_K) + wid * 64; float* li_l = ws; float* al_l = ws + 32;
  float m_reg = -1e30f, l_reg = 0; f32x16 o[8] = {};
  v8i32 q8[2];
  { const bf16* Q8 = Qb + (unsigned)((wid * QBLK + r32) * ldq + hi * 32);
#pragma unroll
    for (int m = 0; m < 2; ++m) { unsigned w[8];
#pragma unroll
      for (int c = 0; c < 4; ++c) bf8_to_f8(*reinterpret_cast<const bf16x8*>(Q8 + m * 64 + c * 8), w[2 * c], w[2 * c + 1]);
      q8[m] = (v8i32){(int)w[0], (int)w[1], (int)w[2], (int)w[3], (int)w[4], (int)w[5], (int)w[6], (int)w[7]}; } }
  char* QL = lds + 2 * SHM_V + 2 * SHM_K + NW * 64 * 4 + wid * 4096 + lane * 32;
  *reinterpret_cast<v8i32*>(QL) = q8[0]; *reinterpret_cast<v8i32*>(QL + 2048) = q8[1];
  asm volatile("s_waitcnt lgkmcnt(0)" ::: "memory");
  const int sr = tid >> 4, sc = (tid & 15) * 8;
  const float dqb = dq0 + (float)(wid * QBLK + r32 - 4 * hi);
  struct { bf16x8 ks0, ks1; u32x4 v, v2; } sr_[SD];
#define SLOAD(i, t_) do { const unsigned io_ = (unsigned)((t0 + (t_)) * 8192 + tid * 16); sr_[i].v = *reinterpret_cast<const u32x4*>(V8a + io_); sr_[i].v2 = *reinterpret_cast<const u32x4*>(V8b + io_); \
    if constexpr (KIMG) sr_[i].ks0 = *reinterpret_cast<const bf16x8*>((const unsigned char*)Kh + io_); \
    else { sr_[i].ks0 = *reinterpret_cast<const bf16x8*>(&Kh[(unsigned)(((t_) * KVBLK + sr) * ldk + sc)]); sr_[i].ks1 = *reinterpret_cast<const bf16x8*>(&Kh[(unsigned)(((t_) * KVBLK + 32 + sr) * ldk + sc)]); } } while (0)
#define SWRITE(b, i) do { *(u32x4*)(V_lds + (b) * SHM_V + tid * 16) = sr_[i].v; *(u32x4*)(V_lds + (b) * SHM_V + 8192 + tid * 16) = sr_[i].v2; \
    if constexpr (KIMG) *(bf16x8*)(K_lds + (b) * SHM_K + tid * 16) = sr_[i].ks0; \
    else { typedef unsigned u32x2_ __attribute__((ext_vector_type(2))); unsigned l0_, h0_, l1_, h1_; bf8_to_f8(sr_[i].ks0, l0_, h0_); bf8_to_f8(sr_[i].ks1, l1_, h1_); \
    *(u32x2_*)(K_lds + (b) * SHM_K + K8OFF(sr, sc >> 4) + ((sc >> 3) & 1) * 8) = (u32x2_){l0_, h0_}; *(u32x2_*)(K_lds + (b) * SHM_K + K8OFF(32 + sr, sc >> 4) + ((sc >> 3) & 1) * 8) = (u32x2_){l1_, h1_}; } } while (0)
#define SWAIT() do { if constexpr (SD == 2) asm volatile("s_waitcnt vmcnt(%0)" :: "n"(KIMG ? 3 : 4) : "memory"); else asm volatile("s_waitcnt vmcnt(0)" ::: "memory"); } while (0)
#define RESC(a) do { if (__any((a) < 1.f)) { if (hi == 0) al_l[r32] = (a); asm volatile("s_waitcnt lgkmcnt(0)" ::: "memory"); \
    _Pragma("unroll") for (int d = 0; d < 8; ++d) _Pragma("unroll") for (int r = 0; r < 16; ++r) o[d][r] *= al_l[crow(r, hi)]; } } while (0)
#define QKT8L(P0_, P1_, KS_, q8_, r32_, hi_, DQ_, SL_) do { v8i32 qq_[2]; qq_[0] = *reinterpret_cast<const v8i32*>(QL); qq_[1] = *reinterpret_cast<const v8i32*>(QL + 2048); qkt8<MODE>(P0_, P1_, KS_, qq_, r32_, hi_, DQ_, SL_); } while (0)
  f32x16 pA0, pA1, pB0, pB1; float mnA, mnB, alA, alB; v8i32 pa;
  constexpr int SE = 0, SO = SD - 1; constexpr float TR = THR8 / SCALE;
  SLOAD(SE, 0); asm volatile("s_waitcnt vmcnt(0)" ::: "memory"); SWRITE(0, SE); __syncthreads();
  QKT8L(pA0, pA1, K_lds, q8, r32, hi, dqb, slopeS); partialSM(pA0, pA1, m_reg, mnA, alA, TR, PSC_LOG2);
  SLOAD(SO, 1); if constexpr (SD == 2) { if (2 < NT) SLOAD(SE, 2); }
  SWAIT(); SWRITE(1, SO); __syncthreads();
  for (int j = 1; j + 1 < NT; j += 2) {
    SBAR(); QKT8L(pB0, pB1, K_lds + SHM_K, q8, r32, hi, dqb - (float)(j * KVBLK), slopeS);
    finishSM8(pA0, pA1, alA, l_reg, pa); SBAR();
    SLOAD(SO, j + SD); SBAR();
    pv8(o, V_lds, pa, r32, hi); pv8(o + 4, V_lds + 8192, pa, r32, hi); partialSM(pB0, pB1, m_reg, mnB, alB, TR, PSC_LOG2);
    __syncthreads(); SWAIT(); SWRITE(0, SE);
    RESC(alB); __syncthreads();
    SBAR(); QKT8L(pA0, pA1, K_lds, q8, r32, hi, dqb - (float)((j + 1) * KVBLK), slopeS);
    finishSM8(pB0, pB1, alB, l_reg, pa); SBAR();
    if (SD == 1 || j + 3 < NT) SLOAD(SE, j + 1 + SD); SBAR();
    pv8(o, V_lds + SHM_V, pa, r32, hi); pv8(o + 4, V_lds + SHM_V + 8192, pa, r32, hi); partialSM(pA0, pA1, m_reg, mnA, alA, TR, PSC_LOG2);
    __syncthreads(); SWAIT(); SWRITE(1, SO);
    RESC(alA); __syncthreads();
  }
  SBAR(); QKT8L(pB0, pB1, K_lds + SHM_K, q8, r32, hi, dqb - (float)((NT - 1) * KVBLK), slopeS);
  finishSM8(pA0, pA1, alA, l_reg, pa); SBAR();
  pv8(o, V_lds, pa, r32, hi); pv8(o + 4, V_lds + 8192, pa, r32, hi); partialSM(pB0, pB1, m_reg, mnB, alB, TR, PSC_LOG2);
  __syncthreads(); RESC(alB);
  finishSM8(pB0, pB1, alB, l_reg, pa); SBAR();
  pv8(o, V_lds + SHM_V, pa, r32, hi); pv8(o + 4, V_lds + SHM_V + 8192, pa, r32, hi);
  if (hi == 0) li_l[r32] = l_reg; asm volatile("s_waitcnt lgkmcnt(0)" ::: "memory");
  float rli[16];
#pragma unroll
  for (int r = 0; r < 16; ++r) rli[r] = __builtin_amdgcn_rcpf(li_l[crow(r, hi)]);
  int ldo = ldo_; asm volatile("" : "+s"(ldo));
  bf16* Ow = Ob + (unsigned)((wid * QBLK) * ldo);
#pragma unroll
  for (int r = 0; r < 16; ++r) { const int orow = crow(r, hi);
#pragma unroll
    for (int d0 = 0; d0 < 8; ++d0) { const float v = o[d0][r] * rli[r]; unsigned u = __builtin_bit_cast(unsigned, v); u = (u + 0x7fffu + ((u >> 16) & 1u)) >> 16; Ow[(unsigned)(orow * ldo + d0 * 32 + r32)] = (bf16)u; } }
#undef QKT8L
#undef SLOAD
#undef SWRITE
#undef SWAIT
#undef RESC
}
__device__ __forceinline__ void v8t_tile(const bf16* __restrict__ Vrows, int ldv, unsigned char* __restrict__ img, __attribute__((address_space(3))) unsigned char* tl, int lane) {
  const int c0 = 8 * (lane & 15);
#pragma unroll 4
  for (int i = 0; i < 16; ++i) { const int key = 4 * i + (lane >> 4), pos = ((key >> 2) & 1) * 32 + (key >> 3) * 4 + (key & 3);
    unsigned lo, hh; bf8_to_f8(*reinterpret_cast<const bf16x8*>(Vrows + (unsigned)(key * ldv + c0)), lo, hh);
#pragma unroll
    for (int e = 0; e < 8; ++e) { const int c = c0 + e; tl[c * 64 + ((((pos >> 4) ^ ((c >> 2) & 3)) << 4) | (pos & 15))] = (unsigned char)(((e < 4 ? lo : hh) >> (8 * (e & 3))) & 0xffu); } }
  asm volatile("s_waitcnt lgkmcnt(0)" ::: "memory");
#pragma unroll
  for (int j = 0; j < 8; ++j) { const int ch = lane + 64 * j; *reinterpret_cast<u32x4*>(img + ch * 16) = *reinterpret_cast<const __attribute__((address_space(3))) u32x4*>(tl + ch * 16); }
  asm volatile("s_waitcnt lgkmcnt(0)" ::: "memory");
}
#undef KSWZ
#undef K8OFF
#undef SBAR
}

#define GAS __attribute__((address_space(1)))
#define LAS __attribute__((address_space(3)))
typedef unsigned short bf16;
typedef unsigned v4u __attribute__((ext_vector_type(4)));
typedef float f32x4 __attribute__((ext_vector_type(4)));
typedef short bf16x8 __attribute__((ext_vector_type(8)));
typedef GAS unsigned gu32;
typedef GAS unsigned long long gu64;
#define RLX_AGENT __ATOMIC_RELAXED, __HIP_MEMORY_SCOPE_AGENT
#define LDS_WAIT() asm volatile("s_waitcnt lgkmcnt(0)" ::: "memory")
#define VM_WAIT() asm volatile("s_waitcnt vmcnt(0)" ::: "memory")
__device__ __forceinline__ unsigned long long rt() { return __builtin_amdgcn_s_memrealtime(); }
__device__ __forceinline__ unsigned f2bf(float f) { unsigned u = __builtin_bit_cast(unsigned, f); return (u + 0x7fffu + ((u >> 16) & 1u)) >> 16; }
__device__ __forceinline__ unsigned pk2(float lo, float hi) { return f2bf(lo) | (f2bf(hi) << 16); }

#define XB_TMO      128
#define XB_XCNT(j)  (256  + 64 * (j))
#define XB_XSUB(j)  (1280 + 64 * (j))
#define XB_XGEN(j)  (2304 + 64 * (j))
#define XB_TOP      3328
#define XB_TOPGEN   3392
#define XCD_BAR_WORDS 3456
#define XB_SPIN_CAP (1u << 18)

__device__ __forceinline__ unsigned xb_ld(unsigned* p)              { return __hip_atomic_load(p, __ATOMIC_RELAXED, __HIP_MEMORY_SCOPE_AGENT); }
__device__ __forceinline__ unsigned xb_add(unsigned* p, unsigned v) { return __hip_atomic_fetch_add(p, v, __ATOMIC_RELAXED, __HIP_MEMORY_SCOPE_AGENT); }
__device__ __forceinline__ unsigned xb_xcc_id() { return (unsigned)__builtin_amdgcn_s_getreg((3 << 11) | 20) & 0xFu; }
#define XB_SPIN(cond, bar) do { unsigned _sp = 0; while (cond) { __builtin_amdgcn_s_sleep(1); \
    if ((++_sp & 255u) == 0u) { if (xb_ld(&(bar)[XB_TMO])) break; if (_sp > XB_SPIN_CAP) { atomicAdd(&(bar)[XB_TMO], 1u); break; } } } } while (0)

struct XcdBarrier {
    unsigned* bar; unsigned x;
    volatile LAS unsigned* st;
};

__device__ __forceinline__ XcdBarrier xcd_barrier_post(unsigned* bar, volatile LAS unsigned* st) {
    XcdBarrier b; b.bar = bar; b.x = xb_xcc_id(); b.st = st;
    if (threadIdx.x == 0) (void)xb_add(&bar[XB_XCNT(b.x)], 1u);
    return b;
}
__device__ __forceinline__ void xcd_barrier_complete(unsigned* bar, unsigned x, unsigned& nloc, unsigned& nx) {
    const unsigned G = gridDim.x * gridDim.y * gridDim.z;
    unsigned sum, cnt, mine, sp = 0u;
    for (;;) {
        sum = 0u; cnt = 0u; mine = 0u;
#pragma unroll
        for (unsigned j = 0; j < 16; ++j) { const unsigned c = xb_ld(&bar[XB_XCNT(j)]); sum += c; cnt += (c > 0u) ? 1u : 0u; mine = (j == x) ? c : mine; }
        if (sum == G) break;
        __builtin_amdgcn_s_sleep(1);
        if ((++sp & 255u) == 0u) { if (xb_ld(&bar[XB_TMO])) break; if (sp > XB_SPIN_CAP) { atomicAdd(&bar[XB_TMO], 1u); break; } }
    }
    nloc = mine > 0u ? mine : 1u; nx = cnt > 0u ? cnt : 1u;
}

__device__ __forceinline__ void xcd_barrier(const XcdBarrier& b) {
    asm volatile("s_waitcnt vmcnt(0)" ::: "memory");
    __syncthreads();
    if (threadIdx.x == 0) {
        unsigned* bar = b.bar;
        __builtin_amdgcn_s_waitcnt(0);
        unsigned nloc = b.st[0], nx = b.st[1];
        if (nloc == 0u) { xcd_barrier_complete(bar, b.x, nloc, nx); b.st[0] = nloc; b.st[1] = nx; }
        const unsigned old = xb_add(&bar[XB_XSUB(b.x)], 1u);
        const unsigned gen = old / nloc;
        if (old + 1u == (gen + 1u) * nloc) {
            __builtin_amdgcn_fence(__ATOMIC_RELEASE, "agent");
            asm volatile("s_waitcnt vmcnt(0)" ::: "memory");
            const unsigned og = xb_add(&bar[XB_TOP], 1u);
            const unsigned tg = og / nx;
            if (og + 1u == (tg + 1u) * nx) xb_add(&bar[XB_TOPGEN], 1u);
            else XB_SPIN(xb_ld(&bar[XB_TOPGEN]) == tg, bar);
            __builtin_amdgcn_fence(__ATOMIC_ACQUIRE, "agent");
            xb_add(&bar[XB_XGEN(b.x)], 1u);
            asm volatile("s_waitcnt vmcnt(0)" ::: "memory");
        } else {
            XB_SPIN(xb_ld(&bar[XB_XGEN(b.x)]) == gen, bar);
            __builtin_amdgcn_fence(__ATOMIC_ACQUIRE, "agent");
            asm volatile("s_waitcnt vmcnt(0)" ::: "memory");
        }
    }
    __syncthreads();
}
#ifndef ATT_SD0
#define ATT_SD0 2
#endif
#ifndef ATT_QK8_GQA
#define ATT_QK8_GQA 1
#endif
#ifndef ATT_GQA_F8
#define ATT_GQA_F8 1
#endif
#ifndef GQA_KIMG
#define GQA_KIMG 1
#endif
#ifndef DIFF_KIMG
#define DIFF_KIMG 1
#endif
#ifndef DIFF_F8_DV2
#define DIFF_F8_DV2 1
#endif
#ifndef DIFF_LSE_WIN
#define DIFF_LSE_WIN 1
#endif
constexpr int LSE_H0 = 3, LSE_NC = 2 * (8 - LSE_H0);
#ifndef DIFF_F8_HMIN
#define DIFF_F8_HMIN 5
#endif
#ifndef ATT_QK8_DIFF
#define ATT_QK8_DIFF 0
#endif
#ifndef ATT_QK8_DIL
#define ATT_QK8_DIL 0
#endif
#ifndef ATT_SD1F
#define ATT_SD1F 1
#endif
#ifndef ATT_SD1
#define ATT_SD1 2
#endif
#ifndef ATT_SD2
#define ATT_SD2 2
#endif
constexpr int NWAVES = 8;
constexpr int BATCH = 2, SEQ = 16384, DM = 2048, T = BATCH * SEQ, HD = 128;
constexpr int L0_IN = 4608, L1_IN = 6144, FF0 = 5632, FFE = 7168, NE = 8;
constexpr float NORM_EPS = 1e-6f;
constexpr float LAMBDA_INIT = 0.35550906759096927f;
constexpr int P_MAX_TILES = 264;
constexpr float SC_WGU = 64.f, SC_WD = 128.f, SC_ACT = 4.f;
#ifndef INPROJ0_F8
#define INPROJ0_F8 2
#endif
#ifndef FFN0_F8
#define FFN0_F8 0
#endif
#ifndef MK_N_LAUNCHES
#define MK_N_LAUNCHES 1
#endif
constexpr int N_PHASES = 20;
constexpr int N_LAUNCHES = MK_N_LAUNCHES;
static_assert(N_LAUNCHES == 1 || N_LAUNCHES == N_PHASES, "MK_N_LAUNCHES is 1 or N_PHASES");

constexpr size_t MiB = 1u << 20;
constexpr size_t WS_CTL = 0, CTL_ZERO_BYTES = 1 * MiB;
constexpr size_t WS_ROPE = 1 * MiB;
constexpr size_t WS_CNT = 1 * MiB + 128 * 1024;
constexpr size_t WS_TOT = 1 * MiB + 192 * 1024;
constexpr size_t WS_TOKE = 2 * MiB;
constexpr size_t WS_TOKG = 3 * MiB;
constexpr size_t WS_TOKS = 4 * MiB;
constexpr size_t WS_LSE = 5 * MiB;
constexpr size_t WS_W8A = 8 * MiB;
constexpr size_t WS_WIN0 = 16 * MiB, WS_WOUT0 = 34 * MiB, WS_WGU0 = 42 * MiB, WS_WD0 = 86 * MiB, WS_WIN1 = 108 * MiB, WS_WOUT1 = 132 * MiB;
constexpr size_t WS_WGUE = 140 * MiB, WS_WDE = 364 * MiB;
constexpr size_t WS_ARENA = 476 * MiB, WS_END = 1840 * MiB;
constexpr size_t A_H = 0, A_PROJ0 = 128 * MiB, A_OB = 416 * MiB, A_MIX = 608 * MiB;
constexpr size_t A_H8A = 736 * MiB;
constexpr size_t A_K8T = 1000 * MiB;
constexpr size_t A_V8T = 992 * MiB;
constexpr size_t A_ACT0 = 128 * MiB;
constexpr size_t A_K8D = 864 * MiB;
constexpr size_t A_V8D = 800 * MiB;
constexpr size_t A_PROJ1 = 128 * MiB, A_OC = 512 * MiB;
constexpr size_t A_XS = 0, A_HFB = 132 * MiB, A_ACT = 196 * MiB, A_Y = 658 * MiB;
static_assert(A_Y + (size_t)P_MAX_TILES * 256 * DM * 2 <= WS_END - WS_ARENA && A_ACT + (size_t)P_MAX_TILES * 256 * FFE <= A_Y && A_XS + (size_t)P_MAX_TILES * 256 * DM <= A_HFB && A_HFB + (size_t)T * DM <= A_ACT, "arena map (MoE)");
static_assert(A_MIX + (size_t)T * DM * 2 <= WS_END - WS_ARENA && A_OC + 2 * (size_t)T * DM * 2 <= WS_END - WS_ARENA && A_ACT0 + (size_t)T * FF0 * 2 <= WS_END - WS_ARENA, "arena map");
static_assert(WS_WDE + (size_t)NE * DM * FFE <= WS_ARENA && WS_WGUE + (size_t)NE * 2 * FFE * DM <= WS_WDE && WS_WOUT1 + (size_t)DM * DM * 2 <= WS_WGUE, "weight map");
constexpr int CW_TMO = 0, CW_CODE = 1;
constexpr int CW_BAR = 4096;
constexpr int CW_Q0 = 8192, CW_Q1 = 8192 + 64, CW_Q2 = 8192 + 128, CW_Q3 = 8192 + 192;
constexpr int CW_PROBE = 8192 + 1024;
constexpr int CW_WIN = 16384;

constexpr int RING_OFF = 0, RING_BYTES = 131072;
constexpr int LDSCTL_OFF = RING_BYTES, MISC_OFF = LDSCTL_OFF + 320;
constexpr int LDS_BYTES = 147456;
static_assert(MISC_OFF + 128 <= LDS_BYTES, "LDS map");

struct Frame {
    LAS unsigned char* lds;
    volatile LAS unsigned* MISC;
    gu32* ctl;
    int vcu, G;
};
typedef float f32x2 __attribute__((ext_vector_type(2)));
typedef int i32x2 __attribute__((ext_vector_type(2)));

__device__ __forceinline__ float wave_sum(float v) {
#pragma unroll
    for (int o = 1; o < 64; o <<= 1) v += __shfl_xor(v, o);
    return v;
}
__device__ __forceinline__ float bflo(unsigned w) { return __uint_as_float(w << 16); }
__device__ __forceinline__ float bfhi(unsigned w) { return __uint_as_float(w & 0xffff0000u); }
__device__ __forceinline__ void unpack8(const v4u w, float (&v)[8]) { v[0] = bflo(w.x); v[1] = bfhi(w.x); v[2] = bflo(w.y); v[3] = bfhi(w.y); v[4] = bflo(w.z); v[5] = bfhi(w.z); v[6] = bflo(w.w); v[7] = bfhi(w.w); }
__device__ __forceinline__ v4u pack8(const float (&v)[8]) { v4u w; w.x = pk2(v[0], v[1]); w.y = pk2(v[2], v[3]); w.z = pk2(v[4], v[5]); w.w = pk2(v[6], v[7]); return w; }

__device__ __forceinline__ void transpose_item(const float* __restrict__ W, int N, bf16* __restrict__ WT, size_t ldt, int k0, int n0, int drow0, LAS float* scr, int lane) {
#pragma unroll 8
    for (int i = 0; i < 32; ++i) { const int kk = 2 * i + (lane >> 5); scr[kk * 33 + (lane & 31)] = W[(size_t)(k0 + kk) * N + n0 + (lane & 31)]; }
    LDS_WAIT(); asm volatile("" ::: "memory");
    const int c = lane & 7;
#pragma unroll
    for (int j = 0; j < 4; ++j) { const int n = (lane >> 3) + 8 * j; const LAS float* s = scr + (8 * c) * 33 + n;
        v4u o; o.x = pk2(s[0 * 33], s[1 * 33]); o.y = pk2(s[2 * 33], s[3 * 33]); o.z = pk2(s[4 * 33], s[5 * 33]); o.w = pk2(s[6 * 33], s[7 * 33]);
        *(v4u*)(WT + (size_t)(drow0 + n) * ldt + k0 + 8 * c) = o; }
    LDS_WAIT(); asm volatile("" ::: "memory");
}
__device__ __forceinline__ void tr_plain(const float* W, int K, int N, bf16* WT, int r, LAS float* scr, int lane) {
    const int nblk = N / 32, kb = r / nblk, nb = r % nblk; transpose_item(W, N, WT, (size_t)K, 64 * kb, 32 * nb, 32 * nb, scr, lane);
}
__device__ __forceinline__ void tr_gu(const float* W, int K, int N, bf16* WT, int half, int r, LAS float* scr, int lane) {
    const int nblk = N / 32, kb = r / nblk, nb = r % nblk, n0 = 32 * nb; transpose_item(W, N, WT, (size_t)K, 64 * kb, n0, (n0 >> 7) * 256 + half * 128 + (n0 & 127), scr, lane);
}
__device__ __forceinline__ unsigned pk4_fp8(float a, float b, float c, float d) { unsigned w = 0u; w = __builtin_amdgcn_cvt_pk_fp8_f32(a, b, w, false); w = __builtin_amdgcn_cvt_pk_fp8_f32(c, d, w, true); return w; }
__device__ __forceinline__ void transpose_item_f8(const float* __restrict__ W, int N, unsigned char* __restrict__ WT, size_t ldt, int k0, int n0, int drow0, float sc, LAS float* scr, int lane) {
#pragma unroll 8
    for (int i = 0; i < 32; ++i) { const int kk = 2 * i + (lane >> 5); scr[kk * 33 + (lane & 31)] = W[(size_t)(k0 + kk) * N + n0 + (lane & 31)]; }
    LDS_WAIT(); asm volatile("" ::: "memory");
    const int c = lane & 3;
#pragma unroll
    for (int j = 0; j < 2; ++j) { const int n = (lane >> 2) + 16 * j; const LAS float* s = scr + (16 * c) * 33 + n;
        v4u o; o.x = pk4_fp8(s[0 * 33] * sc, s[1 * 33] * sc, s[2 * 33] * sc, s[3 * 33] * sc); o.y = pk4_fp8(s[4 * 33] * sc, s[5 * 33] * sc, s[6 * 33] * sc, s[7 * 33] * sc);
        o.z = pk4_fp8(s[8 * 33] * sc, s[9 * 33] * sc, s[10 * 33] * sc, s[11 * 33] * sc); o.w = pk4_fp8(s[12 * 33] * sc, s[13 * 33] * sc, s[14 * 33] * sc, s[15 * 33] * sc);
        *(v4u*)(WT + (size_t)(drow0 + n) * ldt + k0 + 16 * c) = o; }
    LDS_WAIT(); asm volatile("" ::: "memory");
}
__device__ __forceinline__ void tr_plain_f8(const float* W, int K, int N, unsigned char* WT, float sc, int r, LAS float* scr, int lane) {
    const int nblk = N / 32, kb = r / nblk, nb = r % nblk; transpose_item_f8(W, N, WT, (size_t)K, 64 * kb, 32 * nb, 32 * nb, sc, scr, lane);
}
__device__ __forceinline__ void tr_gu_f8(const float* W, int K, int N, unsigned char* WT, int half, float sc, int r, LAS float* scr, int lane) {
    const int nblk = N / 32, kb = r / nblk, nb = r % nblk, n0 = 32 * nb; transpose_item_f8(W, N, WT, (size_t)K, 64 * kb, n0, (n0 >> 7) * 256 + half * 128 + (n0 & 127), sc, scr, lane);
}
__device__ __forceinline__ void rms_row_to_bf16(const float* __restrict__ xrow, const float* __restrict__ g, bf16* __restrict__ orow, int lane) {
    const f32x4* xr = (const f32x4*)xrow + lane;
    f32x4 v[8]; float s = 0.f;
#pragma unroll
    for (int j = 0; j < 8; ++j) { v[j] = xr[64 * j]; s += (v[j].x * v[j].x + v[j].y * v[j].y) + (v[j].z * v[j].z + v[j].w * v[j].w); }
    const float rstd = rsqrtf(wave_sum(s) * (1.f / DM) + NORM_EPS);
    const f32x4* gr = (const f32x4*)g + lane;
    unsigned long long* o8 = (unsigned long long*)orow + lane;
#pragma unroll
    for (int j = 0; j < 8; ++j) { const f32x4 gg = gr[64 * j];
        o8[64 * j] = (unsigned long long)pk2(v[j].x * rstd * gg.x, v[j].y * rstd * gg.y) | ((unsigned long long)pk2(v[j].z * rstd * gg.z, v[j].w * rstd * gg.w) << 32); }
}
__device__ __forceinline__ void rms_row_to_fp8(const float* __restrict__ xrow, const float* __restrict__ g, unsigned char* __restrict__ orow, int lane) {
    const f32x4* xr = (const f32x4*)xrow + lane;
    f32x4 v[8]; float s = 0.f;
#pragma unroll
    for (int j = 0; j < 8; ++j) { v[j] = xr[64 * j]; s += (v[j].x * v[j].x + v[j].y * v[j].y) + (v[j].z * v[j].z + v[j].w * v[j].w); }
    const float rstd = rsqrtf(wave_sum(s) * (1.f / DM) + NORM_EPS);
    const f32x4* gr = (const f32x4*)g + lane;
    unsigned* o4 = (unsigned*)orow + lane;
#pragma unroll
    for (int j = 0; j < 8; ++j) { const f32x4 gg = gr[64 * j]; o4[64 * j] = pk4_fp8(v[j].x * rstd * gg.x, v[j].y * rstd * gg.y, v[j].z * rstd * gg.z, v[j].w * rstd * gg.w); }
}
__device__ __forceinline__ void rms_row_to_both(const float* __restrict__ xrow, const float* __restrict__ g, bf16* __restrict__ orow, unsigned char* __restrict__ orow8, int lane) {
    const f32x4* xr = (const f32x4*)xrow + lane;
    f32x4 v[8]; float s = 0.f;
#pragma unroll
    for (int j = 0; j < 8; ++j) { v[j] = xr[64 * j]; s += (v[j].x * v[j].x + v[j].y * v[j].y) + (v[j].z * v[j].z + v[j].w * v[j].w); }
    const float rstd = rsqrtf(wave_sum(s) * (1.f / DM) + NORM_EPS);
    const f32x4* gr = (const f32x4*)g + lane;
    unsigned long long* o8 = (unsigned long long*)orow + lane; unsigned* o4 = (unsigned*)orow8 + lane;
#pragma unroll
    for (int j = 0; j < 8; ++j) { const f32x4 gg = gr[64 * j]; const float a = v[j].x * rstd * gg.x, b = v[j].y * rstd * gg.y, c = v[j].z * rstd * gg.z, d = v[j].w * rstd * gg.w;
        o8[64 * j] = (unsigned long long)pk2(a, b) | ((unsigned long long)pk2(c, d) << 32); o4[64 * j] = pk4_fp8(a, b, c, d); }
}
__device__ __forceinline__ void norm_rows_phase(int gw, int NGW, int lane, const float* x, const float* g, bf16* Hd) {
    for (int m = gw; m < T; m += NGW) rms_row_to_bf16(x + (size_t)m * DM, g, Hd + (size_t)m * DM, lane);
}

struct Args { const float* in[27]; float* out; unsigned char* ws; int ph_lo, ph_hi; };
static_assert(sizeof(Args) == 27 * 8 + 8 + 8 + 8, "Args has no padding");

#define AS4 __attribute__((address_space(4)))
#define PH_BEGIN int tid = threadIdx.x; asm volatile("" : "+v"(tid)); const int lane = tid & 63, wave = __builtin_amdgcn_readfirstlane(tid >> 6), gw = F.vcu * NWAVES + wave, NGW = F.G * NWAVES; (void)lane; (void)gw; (void)NGW; \
    const AS4 unsigned char* kp = (const AS4 unsigned char*)__builtin_amdgcn_kernarg_segment_ptr(); asm volatile("" : "+s"(kp)); \
    unsigned char* const wsb = *(unsigned char* const AS4*)(kp + 224); unsigned char* const arena = wsb + WS_ARENA; float* const outp = *(float* const AS4*)(kp + 216); (void)arena; (void)outp
#define INP(k) (*(const float* const AS4*)(kp + 8 * (k)))
#define W_IN0 ((bf16*)(wsb + WS_WIN0))
#define W_OUT0 ((bf16*)(wsb + WS_WOUT0))
#define W_GU0 ((bf16*)(wsb + WS_WGU0))
#define W_D0 ((bf16*)(wsb + WS_WD0))
#define W_IN1 ((bf16*)(wsb + WS_WIN1))
#define W_OUT1 ((bf16*)(wsb + WS_WOUT1))
#define W_GUE ((unsigned char*)(wsb + WS_WGUE))
#define W_DE ((unsigned char*)(wsb + WS_WDE))
#define H ((bf16*)(arena + A_H))
#define PROJ0 ((bf16*)(arena + A_PROJ0))
#define OB ((bf16*)(arena + A_OB))
#define MIX ((bf16*)(arena + A_MIX))
#define H8A ((unsigned char*)(arena + A_H8A))
#define W8A ((unsigned char*)(wsb + WS_W8A))
#define V8T ((unsigned char*)(arena + A_V8T))
#define K8T ((unsigned char*)(arena + A_K8T))
#define V8D ((unsigned char*)(arena + A_V8D))
#define K8D ((unsigned char*)(arena + A_K8D))
#define ACT0 ((bf16*)(arena + A_ACT0))
#define PROJ1 ((bf16*)(arena + A_PROJ1))
#define OC ((bf16*)(arena + A_OC))
#define XS ((unsigned char*)(arena + A_XS))
#define ACT ((unsigned char*)(arena + A_ACT))
#define HFB ((unsigned char*)(arena + A_HFB))
#define Y ((bf16*)(arena + A_Y))
#define ROPE ((f32x2*)(wsb + WS_ROPE))
#define LSE ((float*)(wsb + WS_LSE))
#define CNT ((int*)(wsb + WS_CNT))
#define TOT ((int*)(wsb + WS_TOT))
#define TOKE ((i32x2*)(wsb + WS_TOKE))
#define TOKG ((f32x2*)(wsb + WS_TOKG))
#define TOKS ((i32x2*)(wsb + WS_TOKS))
#ifndef CONV_IN_P3
#define CONV_IN_P3 1
#endif
constexpr int MIXA_COLS = 1536;
constexpr int I0 = (DM / 64) * (L0_IN / 32), I1 = (DM / 64) * (DM / 32), I2 = (DM / 64) * (FF0 / 32), I4 = (FF0 / 64) * (DM / 32), I5 = (DM / 64) * (L1_IN / 32);
constexpr int IE = (DM / 64) * (FFE / 32), IED = (FFE / 64) * (DM / 32);
constexpr int NEARLY = I0, NITEMS = I0 + I1 + 2 * I2 + I4 + I5 + I1 + NE * (2 * IE + IED);
constexpr int CONV_BATCH = 512, N_CONV_BATCH = (NITEMS - NEARLY) / CONV_BATCH;
static_assert((NITEMS - NEARLY) % CONV_BATCH == 0 && 3 * N_CONV_BATCH >= 1024, "late conversion items: whole batches, one batch per three GQA units");
#define CONVERT_ITEM(it_) do { int r = (it_); \
            if (r < I0) { if (INPROJ0_F8 == 1) tr_plain_f8(INP(2), DM, L0_IN, (unsigned char*)W_IN0, SC_WGU, r, scr, lane); else if (INPROJ0_F8 == 2 && 32 * (r % (L0_IN / 32)) < MIXA_COLS) tr_plain_f8(INP(2), DM, L0_IN, W8A, SC_WGU, r, scr, lane); else tr_plain(INP(2), DM, L0_IN, W_IN0, r, scr, lane); break; } r -= I0; \
            if (r < I1) { tr_plain(INP(7), DM, DM, W_OUT0, r, scr, lane); break; } r -= I1; \
            if (r < I2) { if (FFN0_F8) tr_gu_f8(INP(9), DM, FF0, (unsigned char*)W_GU0, 0, SC_WGU, r, scr, lane); else tr_gu(INP(9), DM, FF0, W_GU0, 0, r, scr, lane); break; } r -= I2; \
            if (r < I2) { if (FFN0_F8) tr_gu_f8(INP(10), DM, FF0, (unsigned char*)W_GU0, 1, SC_WGU, r, scr, lane); else tr_gu(INP(10), DM, FF0, W_GU0, 1, r, scr, lane); break; } r -= I2; \
            if (r < I4) { tr_plain(INP(11), FF0, DM, W_D0, r, scr, lane); break; } r -= I4; \
            if (r < I5) { tr_plain(INP(13), DM, L1_IN, W_IN1, r, scr, lane); break; } r -= I5; \
            if (r < I1) { tr_plain(INP(21), DM, DM, W_OUT1, r, scr, lane); break; } r -= I1; \
            if (r < NE * IE) { const int e = r / IE; tr_gu_f8(INP(24) + (size_t)e * DM * FFE, DM, FFE, W_GUE + (size_t)e * 2 * FFE * DM, 0, SC_WGU, r % IE, scr, lane); break; } r -= NE * IE; \
            if (r < NE * IE) { const int e = r / IE; tr_gu_f8(INP(25) + (size_t)e * DM * FFE, DM, FFE, W_GUE + (size_t)e * 2 * FFE * DM, 1, SC_WGU, r % IE, scr, lane); break; } r -= NE * IE; \
            { const int e = r / IED; tr_plain_f8(INP(26) + (size_t)e * FFE * DM, FFE, DM, W_DE + (size_t)e * DM * FFE, SC_WD, r % IED, scr, lane); } \
        } while (0)
__global__ void __launch_bounds__(NWAVES * 64, 2) mk_fwd(Args args) {
    extern __shared__ __attribute__((aligned(16))) unsigned char lds[];
    Frame F;
    F.lds = (LAS unsigned char*)lds;
    F.MISC = (volatile LAS unsigned*)(F.lds + MISC_OFF);
    F.G = gridDim.x; { const int bx = blockIdx.x; F.vcu = (F.G % 8 == 0) ? (bx % 8) * (F.G / 8) + bx / 8 : bx; }
    { const AS4 unsigned char* kp0 = (const AS4 unsigned char*)__builtin_amdgcn_kernarg_segment_ptr(); F.ctl = (gu32*)(*(unsigned char* const AS4*)(kp0 + 224) + WS_CTL); }
    for (int u = threadIdx.x; u < (LDS_BYTES - LDSCTL_OFF) / 4; u += NWAVES * 64) ((LAS unsigned*)(F.lds + LDSCTL_OFF))[u] = 0u;
    __syncthreads();
    XcdBarrier bar; bar.bar = (unsigned*)(F.ctl + CW_BAR); bar.x = 0; bar.st = nullptr;
    if (N_LAUNCHES == 1) bar = xcd_barrier_post((unsigned*)(F.ctl + CW_BAR), F.MISC + 8);
#define GRID_BAR() do { if (N_LAUNCHES == 1) { xcd_barrier(bar); } } while (0)
#ifndef STAG_N
#define STAG_N 4
#endif
#define EPI_STAGGER() do { if (STAG_N > 0 && (blockIdx.x & 1)) { for (int q_ = 0; q_ < STAG_N; ++q_) __builtin_amdgcn_s_sleep(127); } } while (0)
    int lo, hi; { const AS4 unsigned char* kp0 = (const AS4 unsigned char*)__builtin_amdgcn_kernarg_segment_ptr(); lo = *(const AS4 int*)(kp0 + 232); hi = *(const AS4 int*)(kp0 + 236); }
#ifndef PROBE_DUP
#define PROBE_DUP 0u
#endif
#define REPS(k) (1 + (int)((PROBE_DUP >> (k)) & 1u))
#ifndef PROBE_BARS
#define PROBE_BARS 0
#endif
#ifndef PROBE_ATT
#define PROBE_ATT 0
#endif
#ifndef PH_MASK
#define PH_MASK 0xffffffffu
#endif
#define IN(k) (((PH_MASK >> (k)) & 1u) && lo <= (k) && (k) < hi)
#define SEAM(k) do { if (IN(k) && IN((k) + 1)) GRID_BAR(); } while (0)
    for (int rep_ = 0; rep_ < (IN(0) ? REPS(0) : 0); ++rep_) {
        PH_BEGIN;
        LAS float* scr = (LAS float*)(F.lds + RING_OFF + wave * 16384);
        for (int it = gw; it < (CONV_IN_P3 ? NEARLY : NITEMS); it += NGW) CONVERT_ITEM(it);
        for (int i = blockIdx.x * (NWAVES * 64) + tid; i < 256 * 32; i += F.G * NWAVES * 64) {
            const int idx = i >> 5, f = i & 31;
            const float inv = exp2f(-(float)f * (13.287712379549449f / 32.f));
            const float ang = (float)idx * inv;
            const float k = rintf(ang * 0.15915494309189535f);
            float rr = fmaf(-k, 6.28125f, ang); rr = fmaf(-k, 1.9353071795864769e-3f, rr);
            ROPE[i] = (f32x2){cosf(rr), sinf(rr)};
        }
        if (INPROJ0_F8 == 1) { for (int m = gw; m < T; m += NGW) rms_row_to_fp8(INP(0) + (size_t)m * DM, INP(1), (unsigned char*)H + (size_t)m * DM, lane); }
        else if (INPROJ0_F8 == 2) { for (int m = gw; m < T; m += NGW) rms_row_to_both(INP(0) + (size_t)m * DM, INP(1), H + (size_t)m * DM, H8A + (size_t)m * DM, lane); }
        else norm_rows_phase(gw, NGW, lane, INP(0), INP(1), H);
    }
    SEAM(0);
    for (int rep_ = 0; rep_ < (IN(1) ? REPS(1) : 0); ++rep_) {
        PH_BEGIN;
        if (INPROJ0_F8 == 2) {
            { pg8::Gemm g{(const bf16*)H8A, (const bf16*)W8A, T, MIXA_COLS, DM / 2}; pg8::StaticOrder S; S.init(T, MIXA_COLS, F.G, (int)blockIdx.x);
              pg8::EpiBf16 E{PROJ0, L0_IN, 1.f / SC_WGU};
              pg8::gemm_phase<pg8::EpiBf16, pg8::StaticOrder, true, true, true>(F.lds + RING_OFF, g, S, E); }
            __syncthreads();
            { pg8::Gemm g{H, W_IN0 + (size_t)MIXA_COLS * DM, T, L0_IN - MIXA_COLS, DM}; pg8::StaticOrder S; S.init(T, L0_IN - MIXA_COLS, F.G, (int)blockIdx.x);
              pg8::EpiBf16 E{PROJ0 + MIXA_COLS, L0_IN, 1.f};
              pg8::gemm_phase<pg8::EpiBf16, pg8::StaticOrder, true, true, false>(F.lds + RING_OFF, g, S, E); }
        } else {
        pg8::Gemm g{H, W_IN0, T, L0_IN, INPROJ0_F8 ? DM / 2 : DM}; pg8::StaticOrder S; S.init(T, L0_IN, F.G, (int)blockIdx.x);
        pg8::EpiBf16 E{PROJ0, L0_IN, INPROJ0_F8 ? 1.f / SC_WGU : 1.f};
        pg8::gemm_phase<pg8::EpiBf16, pg8::StaticOrder, true, true, (INPROJ0_F8 == 1)>(F.lds + RING_OFF, g, S, E);
        }
    }
    SEAM(1);
    for (int rep_ = 0; rep_ < (IN(2) ? REPS(2) : 0); ++rep_) {
        PH_BEGIN;
        const int sub = lane >> 4, j = lane & 15;
        LAS unsigned char* kimg = F.lds + RING_OFF;
        for (int c = blockIdx.x; c < 256; c += F.G) {
        __syncthreads();
        for (int i = wave; i < 128; i += NWAVES) {
            const int t = c * 128 + i;
            const int s = t % SEQ, prow = s >> 6, pcol = s & 63;
            bf16* row = PROJ0 + (size_t)t * L0_IN;
#pragma unroll
            for (int seg = 0; seg < 4; ++seg) {
                const int col0 = seg == 0 ? 0 : seg == 1 ? 1024 : seg == 2 ? 1536 : 2560;
                const int nh = seg == 1 ? 2 : 8;
                const float* g = INP(3 + seg);
                const bool rope = seg < 2;
                const f32x4 ga = *(const f32x4*)(g + j * 8), gb = *(const f32x4*)(g + j * 8 + 4);
                for (int it = 0; it * 4 < nh; ++it) {
                    const int head = it * 4 + sub; const bool act = head < nh;
                    bf16* p = row + col0 + (act ? head : 0) * HD + j * 8;
                    const v4u w = *(const v4u*)p;
                    float v[8]; unpack8(w, v);
                    float ss = 0.f;
#pragma unroll
                    for (int i = 0; i < 8; ++i) ss += v[i] * v[i];
                    ss += __shfl_xor(ss, 1); ss += __shfl_xor(ss, 2); ss += __shfl_xor(ss, 4); ss += __shfl_xor(ss, 8);
                    const float rstd = rsqrtf(ss * (1.f / HD) + NORM_EPS);
                    v[0] *= rstd * ga.x; v[1] *= rstd * ga.y; v[2] *= rstd * ga.z; v[3] *= rstd * ga.w; v[4] *= rstd * gb.x; v[5] *= rstd * gb.y; v[6] *= rstd * gb.z; v[7] *= rstd * gb.w;
                    if (rope) {
                        const int idx = (j < 8) ? prow : pcol; const f32x4* cs = (const f32x4*)(ROPE + idx * 32 + 8 * (j & 3));
                        const float sgn = (j & 4) ? 1.f : -1.f;
#pragma unroll
                        for (int q = 0; q < 4; ++q) { const f32x4 c2 = cs[q];
                            const float pa = __shfl_xor(v[2 * q], 4), pb = __shfl_xor(v[2 * q + 1], 4);
                            v[2 * q] = v[2 * q] * c2.x + sgn * pa * c2.y; v[2 * q + 1] = v[2 * q + 1] * c2.z + sgn * pb * c2.w; }
                    }
                    if (act) { const v4u pw = pack8(v); *(v4u*)p = pw;
                        if (GQA_KIMG && seg == 1) { unsigned lo8, hi8; att::bf8_to_f8(__builtin_bit_cast(att::bf16x8, pw), lo8, hi8); typedef unsigned u32x2_ __attribute__((ext_vector_type(2)));
                            *(LAS u32x2_*)(kimg + (((i >> 6) * 2 + head) * 8192 + att::k8off(i & 63, j >> 1) + (j & 1) * 8)) = (u32x2_){lo8, hi8}; } }
                }
            }
        }
        __syncthreads();
        if (GQA_KIMG) { const int bb = c >> 7, t0 = (c & 127) * 2;
            for (int q = tid; q < 4 * 512; q += NWAVES * 64) { const int img = q >> 9, tl = img >> 1, kvh = img & 1;
                *(v4u*)(K8T + ((size_t)((bb * 2 + kvh) * 256 + t0 + tl) * 8192 + (q & 511) * 16)) = *(const LAS v4u*)(kimg + (size_t)q * 16); } }
        }
        if (ATT_GQA_F8) {
            __syncthreads();
            for (int tile = gw; tile < 1024; tile += NGW) { const int b = tile >> 9, kvh = (tile >> 8) & 1, t = tile & 255;
                att::v8t_tile(PROJ0 + ((size_t)b * SEQ + t * 64) * L0_IN + 1280 + kvh * HD, L0_IN, V8T + (size_t)tile * 8192, F.lds + RING_OFF + wave * 16384, lane); }
        }
    }
    SEAM(2);
    for (int rep_ = 0; rep_ < (IN(3) ? REPS(3) : 0); ++rep_) {
        PH_BEGIN;
#ifndef P3_PART
#define P3_PART 3
#endif
        if (P3_PART & 1) {
        gu32* head = F.ctl + CW_Q0 + 256 * rep_;
        LAS float* scr = (LAS float*)(F.lds + RING_OFF + wave * 16384);
        for (;;) {
            __syncthreads();
            if (tid == 0) F.MISC[16] = __hip_atomic_fetch_add(head, 1u, RLX_AGENT);
            __syncthreads();
            int u = __builtin_amdgcn_readfirstlane((int)F.MISC[16]);
            if (CONV_IN_P3) { const int e = u;
                if (e >= 4 * N_CONV_BATCH) break;
                if ((e & 3) == 3) { const int it0 = NEARLY + (e >> 2) * CONV_BATCH + wave * (CONV_BATCH / NWAVES);
                    for (int k = 0; k < CONV_BATCH / NWAVES; ++k) CONVERT_ITEM(it0 + k);
                    continue; }
                u = 3 * (e >> 2) + (e & 3);
                if (u >= 1024) continue;
            } else if (u >= 1024) break;
            const int g = u & 3, qb = (u >> 2) & 63, kvh = (u >> 8) & 1, b = u >> 9, hq = kvh * 4 + g;
            const bf16* base = PROJ0 + (size_t)b * SEQ * L0_IN;
            if (ATT_GQA_F8) att::attn_unit_f8<0, ATT_SD0, (GQA_KIMG != 0)>(base + (size_t)(qb * 256) * L0_IN + hq * HD, L0_IN, GQA_KIMG ? (const bf16*)(K8T + (size_t)(b * 2 + kvh) * 256 * 8192) : base + 1024 + kvh * HD, L0_IN, V8T + (size_t)(b * 2 + kvh) * 256 * 8192,
                              MIX + ((size_t)b * SEQ + qb * 256) * DM + hq * HD, DM, SEQ / 64, 0, 0.f, 0.f, (char*)lds + RING_OFF);
            else att::attn_unit<0, ATT_SD0, ATT_QK8_GQA>(base + (size_t)(qb * 256) * L0_IN + hq * HD, L0_IN, base + 1024 + kvh * HD, base + 1280 + kvh * HD, L0_IN,
                              MIX + ((size_t)b * SEQ + qb * 256) * DM + hq * HD, DM, nullptr, 0, SEQ / 64, 0.f, 0.f, (char*)lds + RING_OFF);
        }
        }
        if (P3_PART & 2) {
        gu32* head = F.ctl + CW_Q2 + 256 * rep_;
        for (;;) {
            __syncthreads();
            if (tid == 0) F.MISC[16] = __hip_atomic_fetch_add(head, 1u, RLX_AGENT);
            __syncthreads();
            const int v = __builtin_amdgcn_readfirstlane((int)F.MISC[16]);
            if (v >= 3072) break;
            const int rb = v & 63, h = (v >> 6) & 7, b = (v >> 9) & 1, p = v >> 10;
            const int dil = p == 0 ? 1 : p == 1 ? 4 : 16, L = SEQ / dil, nblk = L / 256, res = rb / nblk, blk = rb % nblk;
            const int q0 = blk * 256; int ks = q0 - 64; ks = ks < 0 ? 0 : ks; ks = ks > L - 384 ? L - 384 : ks;
            const bf16* base = PROJ0 + (size_t)b * SEQ * L0_IN;
            const float slope = exp2f(-(float)(h + 1));
            att::attn_unit<2, ATT_SD2, ATT_QK8_DIL>(base + (size_t)(q0 * dil + res) * L0_IN + 1536 + h * HD, dil * L0_IN,
                              base + (size_t)(ks * dil + res) * L0_IN + 2560 + h * HD, base + (size_t)(ks * dil + res) * L0_IN + 3584 + h * HD, dil * L0_IN,
                              OB + (size_t)p * T * 1024 + ((size_t)b * SEQ + q0 * dil + res) * 1024 + h * HD, dil * 1024,
                              LSE + (size_t)p * T * 8 + ((size_t)b * SEQ + q0 * dil + res) * 8 + h, dil * 8, 6, (float)(q0 - ks), slope * (float)dil * (1.0f / att::SCALE), (char*)lds + RING_OFF);
        }
        }
    }
    SEAM(3);
#if PROBE_ATT
    for (int rep_ = 0; rep_ < (IN(4) ? 1 : 0); ++rep_) {
        PH_BEGIN;
        bf16* SCR = (bf16*)(arena + A_MIX + 128 * MiB) + (size_t)blockIdx.x * 2 * 256 * 128;
        float* SCRL = (float*)(arena + A_MIX + 256 * MiB) + (size_t)blockIdx.x * 256;
        {
            __syncthreads();
            int mism = 0;
            {
                const int u = (int)blockIdx.x * 4 + ((int)blockIdx.x & 3);
                const int g = u & 3, qb = (u >> 2) & 63, kvh = (u >> 8) & 1, b = u >> 9, hq = kvh * 4 + g;
                const bf16* base = PROJ0 + (size_t)b * SEQ * L0_IN;
                int ntv = SEQ / 64, q0v = qb * 256; asm volatile("" : "+v"(ntv), "+v"(q0v));
                att::attn_unit<1, 2>(base + (size_t)q0v * L0_IN + hq * HD, L0_IN, base + 1024 + kvh * HD, base + 1280 + kvh * HD, L0_IN, SCR, 128, nullptr, 0, ntv, (float)q0v, 0.f, (char*)lds + RING_OFF);
                asm volatile("s_waitcnt vmcnt(0)" ::: "memory"); __syncthreads();
                const bf16* ref = MIX + ((size_t)b * SEQ + qb * 256) * DM + hq * HD;
                int nbad = 0;
                for (int e = tid; e < 256 * 128; e += NWAVES * 64) { const int r = e >> 7, cc = e & 127; const float a_ = bflo((unsigned)ref[(size_t)r * DM + cc]), b_ = bflo((unsigned)SCR[r * 128 + cc]); if (!(fabsf(a_ - b_) <= 0.25f * fabsf(b_) + 0.004f)) ++nbad; }
                if ((ATT_QK8_GQA || ATT_GQA_F8) ? (nbad > 8) : (nbad > 0)) mism = 1;
            }
            if (mism) __hip_atomic_fetch_or(F.ctl + CW_PROBE, 1u, RLX_AGENT);
        }
        {
            __syncthreads();
            int mism = 0;
            {
                bf16* const SCR2 = SCR + 256 * 128;
                const int v = (int)blockIdx.x * 12 + ((int)blockIdx.x % 11);
                const int rb = v & 63, h = (v >> 6) & 7, b = (v >> 9) & 1, p = v >> 10;
                const int dil = p == 0 ? 1 : p == 1 ? 4 : 16, L = SEQ / dil, nblk = L / 256, res = rb / nblk, blk = rb % nblk;
                int q0 = blk * 256; int ks = q0 - 64; ks = ks < 0 ? 0 : ks; ks = ks > L - 384 ? L - 384 : ks;
                int ntv = 6; asm volatile("" : "+v"(ntv), "+v"(q0), "+v"(ks));
                const bf16* base = PROJ0 + (size_t)b * SEQ * L0_IN;
                const float slope = exp2f(-(float)(h + 1));
                att::attn_unit<2, 2>(base + (size_t)(q0 * dil + res) * L0_IN + 1536 + h * HD, dil * L0_IN,
                                  base + (size_t)(ks * dil + res) * L0_IN + 2560 + h * HD, base + (size_t)(ks * dil + res) * L0_IN + 3584 + h * HD, dil * L0_IN,
                                  SCR2, 128, SCRL, 1, ntv, (float)(q0 - ks), slope * (float)dil * (1.0f / att::SCALE), (char*)lds + RING_OFF);
                asm volatile("s_waitcnt vmcnt(0)" ::: "memory"); __syncthreads();
                const bf16* ref = OB + (size_t)p * T * 1024 + ((size_t)b * SEQ + q0 * dil + res) * 1024 + h * HD;
                const float* refl = LSE + (size_t)p * T * 8 + ((size_t)b * SEQ + q0 * dil + res) * 8 + h;
                for (int e = tid; e < 256 * 128; e += NWAVES * 64) { const int r = e >> 7, cc = e & 127; if (ref[(size_t)r * dil * 1024 + cc] != SCR2[r * 128 + cc]) mism = 1; }
                if (tid < 256) { if (refl[(size_t)tid * dil * 8] != SCRL[tid]) mism = 1; }
            }
            if (mism) __hip_atomic_fetch_or(F.ctl + CW_PROBE, 1u, RLX_AGENT);
        }
    }
#endif
    for (int rep_ = 0; rep_ < (IN(4) ? REPS(4) : 0); ++rep_) {
        PH_BEGIN;
        for (int t = gw; t < T; t += NGW) {
#pragma unroll
            for (int jj = 0; jj < 2; ++jj) { const int col = 8 * (lane + 64 * jj), h = col >> 7;
                const float l0 = LSE[(size_t)t * 8 + h], l1 = LSE[(size_t)T * 8 + (size_t)t * 8 + h], l2 = LSE[(size_t)2 * T * 8 + (size_t)t * 8 + h];
                const float mx = fmaxf(l0, fmaxf(l1, l2)); float e0 = __expf(l0 - mx), e1 = __expf(l1 - mx), e2 = __expf(l2 - mx); const float inv = 1.f / (e0 + e1 + e2); e0 *= inv; e1 *= inv; e2 *= inv;
                float a[8], b8[8], c8[8], o[8];
                unpack8(*(const v4u*)(OB + (size_t)t * 1024 + col), a); unpack8(*(const v4u*)(OB + (size_t)T * 1024 + (size_t)t * 1024 + col), b8); unpack8(*(const v4u*)(OB + (size_t)2 * T * 1024 + (size_t)t * 1024 + col), c8);
#pragma unroll
                for (int i = 0; i < 8; ++i) o[i] = e0 * a[i] + e1 * b8[i] + e2 * c8[i];
                *(v4u*)(MIX + (size_t)t * DM + 1024 + col) = pack8(o); }
        }
    }
    SEAM(4);
#if PROBE_BARS
    for (int xb_ = 0; xb_ < PROBE_BARS; ++xb_) GRID_BAR();
#endif
    for (int rep_ = 0; rep_ < (IN(5) ? REPS(5) : 0); ++rep_) {
        PH_BEGIN;
        pg8::Gemm g{MIX, W_OUT0, T, DM, DM}; pg8::StaticOrder S; S.init(T, DM, F.G, (int)blockIdx.x);
        pg8::EpiRes E{INP(0), outp, DM};
        EPI_STAGGER();
        pg8::gemm_phase<pg8::EpiRes, pg8::StaticOrder, true, true>(F.lds + RING_OFF, g, S, E);
    }
    SEAM(5);
    for (int rep_ = 0; rep_ < (IN(6) ? REPS(6) : 0); ++rep_) { PH_BEGIN; if (FFN0_F8) { for (int m = gw; m < T; m += NGW) rms_row_to_fp8(outp + (size_t)m * DM, INP(8), (unsigned char*)H + (size_t)m * DM, lane); } else norm_rows_phase(gw, NGW, lane, outp, INP(8), H); }
    SEAM(6);
    for (int rep_ = 0; rep_ < (IN(7) ? REPS(7) : 0); ++rep_) {
        PH_BEGIN;
        pg8::Gemm g{H, W_GU0, T, 2 * FF0, FFN0_F8 ? DM / 2 : DM}; pg8::StaticOrder S; S.init(T, 2 * FF0, F.G, (int)blockIdx.x);
        pg8::EpiSwiglu E{ACT0, FF0, FFN0_F8 ? 1.f / SC_WGU : 1.f};
        pg8::gemm_phase<pg8::EpiSwiglu, pg8::StaticOrder, true, true, (FFN0_F8 != 0)>(F.lds + RING_OFF, g, S, E);
    }
    SEAM(7);
    for (int rep_ = 0; rep_ < (IN(8) ? REPS(8) : 0); ++rep_) {
        PH_BEGIN;
        pg8::Gemm g{ACT0, W_D0, T, DM, FF0}; pg8::StaticOrder S; S.init(T, DM, F.G, (int)blockIdx.x);
        pg8::EpiRes E{outp, outp, DM};
        EPI_STAGGER();
        pg8::gemm_phase<pg8::EpiRes, pg8::StaticOrder, true, true>(F.lds + RING_OFF, g, S, E);
    }
    SEAM(8);
    for (int rep_ = 0; rep_ < (IN(9) ? REPS(9) : 0); ++rep_) { PH_BEGIN; norm_rows_phase(gw, NGW, lane, outp, INP(12), H); }
    SEAM(9);
    for (int rep_ = 0; rep_ < (IN(10) ? REPS(10) : 0); ++rep_) {
        PH_BEGIN;
        pg8::Gemm g{H, W_IN1, T, L1_IN, DM}; pg8::StaticOrder S; S.init(T, L1_IN, F.G, (int)blockIdx.x);
        pg8::EpiBf16 E{PROJ1, L1_IN, 1.f};
        pg8::gemm_phase<pg8::EpiBf16, pg8::StaticOrder, true, true>(F.lds + RING_OFF, g, S, E);
    }
    SEAM(10);
    for (int rep_ = 0; rep_ < (IN(11) ? REPS(11) : 0); ++rep_) {
        PH_BEGIN;
        const int sub = lane >> 4, j = lane & 15;
        const f32x4 qa = *(const f32x4*)(INP(14) + j * 8), qb4 = *(const f32x4*)(INP(14) + j * 8 + 4), ka = *(const f32x4*)(INP(15) + j * 8), kb4 = *(const f32x4*)(INP(15) + j * 8 + 4);
        unsigned* wtab = (unsigned*)(F.ctl + CW_WIN);
        LAS unsigned* lst = (LAS unsigned*)(F.lds + RING_OFF);
        constexpr int NC8 = (DIFF_KIMG && DIFF_F8_HMIN < 8) ? 2 * (8 - DIFF_F8_HMIN) : 0;
        LAS unsigned char* kimg = F.lds + RING_OFF + 4096;
        for (int c = blockIdx.x; c < 256; c += F.G) {
            __syncthreads();
            if (tid < 48) lst[tid] = 0u;
            __syncthreads();
            float mq[4] = {0.f, 0.f, 0.f, 0.f}, mb[4] = {0.f, 0.f, 0.f, 0.f}, mk[4] = {0.f, 0.f, 0.f, 0.f};
            for (int i = wave; i < 128; i += NWAVES) {
                const int t = c * 128 + i;
                bf16* row = PROJ1 + (size_t)t * L1_IN;
                float qv[4][8]; float nq2[4];
#pragma unroll
                for (int it = 0; it < 8; ++it) {
                    const int head = it * 4 + sub; bf16* p = row + head * HD + j * 8;
                    const v4u w = *(const v4u*)p; float v[8]; unpack8(w, v);
                    float ss = 0.f;
#pragma unroll
                    for (int i2 = 0; i2 < 8; ++i2) ss += v[i2] * v[i2];
                    ss += __shfl_xor(ss, 1); ss += __shfl_xor(ss, 2); ss += __shfl_xor(ss, 4); ss += __shfl_xor(ss, 8);
                    const float rstd = rsqrtf(ss * (1.f / HD) + NORM_EPS);
                    const f32x4 ga = it < 4 ? qa : ka, gb = it < 4 ? qb4 : kb4;
                    v[0] *= rstd * ga.x; v[1] *= rstd * ga.y; v[2] *= rstd * ga.z; v[3] *= rstd * ga.w; v[4] *= rstd * gb.x; v[5] *= rstd * gb.y; v[6] *= rstd * gb.z; v[7] *= rstd * gb.w;
                    const v4u pw = pack8(v);
                    *(v4u*)p = pw;
                    float vr[8]; unpack8(pw, vr);
                    float n2 = 0.f, dt = 0.f;
#pragma unroll
                    for (int i2 = 0; i2 < 8; ++i2) { n2 += vr[i2] * vr[i2]; if (it >= 4) dt += vr[i2] * qv[it & 3][i2]; else qv[it & 3][i2] = vr[i2]; }
                    n2 += __shfl_xor(n2, 1); n2 += __shfl_xor(n2, 2); n2 += __shfl_xor(n2, 4); n2 += __shfl_xor(n2, 8);
                    if (it < 4) nq2[it] = n2;
                    else {
                        dt += __shfl_xor(dt, 1); dt += __shfl_xor(dt, 2); dt += __shfl_xor(dt, 4); dt += __shfl_xor(dt, 8);
                        mq[it & 3] = fmaxf(mq[it & 3], sqrtf(nq2[it & 3])); mb[it & 3] = fmaxf(mb[it & 3], 64.f - dt * att::SCALE); mk[it & 3] = fmaxf(mk[it & 3], sqrtf(n2));
                        if (NC8 > 0) { const int comp = (it - 4) * 4 + sub;
                            if (comp >= 16 - NC8) { unsigned lo8, hi8; att::bf8_to_f8(__builtin_bit_cast(att::bf16x8, pw), lo8, hi8); typedef unsigned u32x2_ __attribute__((ext_vector_type(2)));
                                *(LAS u32x2_*)(kimg + (((i >> 6) * NC8 + (comp - (16 - NC8))) * 8192 + att::k8off(i & 63, j >> 1) + (j & 1) * 8)) = (u32x2_){lo8, hi8}; } }
                    }
                }
            }
            if (j == 0) {
#pragma unroll
                for (int q = 0; q < 4; ++q) { const int comp = q * 4 + sub;
                    __hip_atomic_fetch_max(lst + comp, __float_as_uint(mq[q]), __ATOMIC_RELAXED, __HIP_MEMORY_SCOPE_WORKGROUP);
                    __hip_atomic_fetch_max(lst + 16 + comp, __float_as_uint(mb[q]), __ATOMIC_RELAXED, __HIP_MEMORY_SCOPE_WORKGROUP);
                    __hip_atomic_fetch_max(lst + 32 + comp, __float_as_uint(mk[q]), __ATOMIC_RELAXED, __HIP_MEMORY_SCOPE_WORKGROUP); }
            }
            __syncthreads();
            if (NC8 > 0) { const int bb = c >> 7, t0 = (c & 127) * 2;
                for (int q = tid; q < 2 * NC8 * 512; q += NWAVES * 64) { const int img = q >> 9, tl = img / NC8, cc = 16 - NC8 + img % NC8;
                    *(v4u*)(K8D + ((size_t)((bb * 16 + cc) * 256 + t0 + tl) * 8192 + (q & 511) * 16)) = *(const LAS v4u*)(kimg + (size_t)q * 16); } }
            if (tid < 48) { const int which = tid >> 4, comp = tid & 15, bb = c >> 7, qblk = (c & 127) >> 1; const unsigned v = lst[tid];
                if (which == 0) atomicMax(wtab + (bb * 16 + comp) * 64 + qblk, v);
                else if (which == 1) atomicMax(wtab + 2048 + (bb * 16 + comp) * 64 + qblk, v);
                else atomicMax(wtab + 4096 + bb * 16 + comp, v); }
        }
        if (DIFF_F8_HMIN < 8) {
            __syncthreads();
            constexpr int NH8 = 8 - DIFF_F8_HMIN;
            for (int q = gw; q < 2 * NH8 * 2 * 256; q += NGW) { const int t = q & 255, vh = (q >> 8) & 1, hh = (q >> 9) % NH8, b = (q >> 9) / NH8, h = DIFF_F8_HMIN + hh;
                att::v8t_tile(PROJ1 + ((size_t)b * SEQ + t * 64) * L1_IN + 4096 + h * 256 + vh * HD, L1_IN, V8D + (size_t)(((b * 8 + h) * 2 + vh) * 256 + t) * 8192, F.lds + RING_OFF + wave * 16384, lane); }
        }
    }
    SEAM(11);
    for (int rep_ = 0; rep_ < (IN(12) ? REPS(12) : 0); ++rep_) {
        PH_BEGIN;
        const gu32* wtab = F.ctl + CW_WIN;
        if (DIFF_LSE_WIN && N_LAUNCHES == 1) {
            static_assert(DIFF_F8_HMIN >= LSE_H0, "every e4m3-body head takes its window statistics from the pre-pass");
            const int sr = tid >> 4, sc = (tid & 15) * 8, wv = tid >> 6, r32 = lane & 31, hi = lane >> 5;
            att::bf16x8 ks[8], qr[8], ksn[8], qrn[8];
#define LSE_LOAD(KS_, QR_, u_) do { const int qb_ = (u_) & 63, comp_ = 2 * LSE_H0 + ((u_) >> 6) % LSE_NC, b_ = ((u_) >> 6) / LSE_NC; const bf16* blk_ = PROJ1 + ((size_t)b_ * SEQ + qb_ * 256) * L1_IN + comp_ * HD; \
                _Pragma("unroll") for (int i = 0; i < 8; ++i) KS_[i] = *reinterpret_cast<const att::bf16x8*>(blk_ + 2048 + (unsigned)((32 * i + sr) * L1_IN + sc)); \
                _Pragma("unroll") for (int d0 = 0; d0 < 8; ++d0) QR_[d0] = *reinterpret_cast<const att::bf16x8*>(blk_ + (unsigned)((wv * 32 + r32) * L1_IN + hi * 8 + d0 * 16)); } while (0)
            if ((int)blockIdx.x < 128 * LSE_NC) LSE_LOAD(ksn, qrn, (int)blockIdx.x);
            for (int u = blockIdx.x; u < 128 * LSE_NC; u += F.G) {
                const int qb = u & 63, comp = 2 * LSE_H0 + (u >> 6) % LSE_NC, b = (u >> 6) / LSE_NC;
#pragma unroll
                for (int i = 0; i < 8; ++i) { ks[i] = ksn[i]; qr[i] = qrn[i]; }
                asm volatile("s_waitcnt vmcnt(0)" ::: "memory");
                __syncthreads();
                if (u + F.G < 128 * LSE_NC) LSE_LOAD(ksn, qrn, u + F.G);
                const float slope = exp2f(-(float)((comp >> 1) + 1));
                const bool f8c = comp >= 2 * DIFF_F8_HMIN;
                float qn2 = 0.f, kn2 = 0.f;
                if (f8c) {
#pragma unroll
                    for (int i = 0; i < 8; ++i) { qr[i] = att::round_f8(qr[i], qn2); float kn = 0.f; ks[i] = att::round_f8(ks[i], kn);
                        kn += __shfl_xor(kn, 1); kn += __shfl_xor(kn, 2); kn += __shfl_xor(kn, 4); kn += __shfl_xor(kn, 8); kn2 = fmaxf(kn2, kn); }
                    qn2 += __shfl_xor(qn2, 32);
                    qn2 = fmaxf(qn2, __shfl_xor(qn2, 1)); qn2 = fmaxf(qn2, __shfl_xor(qn2, 2)); qn2 = fmaxf(qn2, __shfl_xor(qn2, 4)); qn2 = fmaxf(qn2, __shfl_xor(qn2, 8)); qn2 = fmaxf(qn2, __shfl_xor(qn2, 16));
                    kn2 = fmaxf(kn2, __shfl_xor(kn2, 16)); kn2 = fmaxf(kn2, __shfl_xor(kn2, 32));
                }
                float v = att::lse_block(ks, qr, slope * (1.0f / att::SCALE), (char*)lds + RING_OFF);
                v = fminf(v, __shfl_xor(v, 1)); v = fminf(v, __shfl_xor(v, 2)); v = fminf(v, __shfl_xor(v, 4)); v = fminf(v, __shfl_xor(v, 8)); v = fminf(v, __shfl_xor(v, 16));
                LAS float* red = (LAS float*)(F.lds + RING_OFF + 65536);
                if (lane == 0) { red[wave] = v; red[8 + wave] = qn2; red[16 + wave] = kn2; }
                __syncthreads();
                if (tid == 0) { float mn = red[0], qm = red[8], km = red[16];
#pragma unroll
                    for (int k = 1; k < NWAVES; ++k) { mn = fminf(mn, red[k]); qm = fmaxf(qm, red[8 + k]); km = fmaxf(km, red[16 + k]); }
                    __hip_atomic_store((gu32*)wtab + 4608 + (b * 16 + comp) * 64 + qb, __float_as_uint(mn), RLX_AGENT);
                    if (f8c) { __hip_atomic_store((gu32*)wtab + 6656 + (b * 16 + comp) * 64 + qb, __float_as_uint(sqrtf(qm)), RLX_AGENT);
                        atomicMax((unsigned*)wtab + 8704 + b * 16 + comp, __float_as_uint(sqrtf(km))); } }
            }
#undef LSE_LOAD
            GRID_BAR();
        }
#define WLD(i) __uint_as_float((unsigned)__builtin_amdgcn_readfirstlane((int)__hip_atomic_load((const gu32*)wtab + (i), RLX_AGENT)))
#if PROBE_ATT
#define WIN_PROBE(F8_) { const float sp0_ = ((F8_ ? 1.258f : 1.f) * qmx * kmx * att::SCALE - smin) * 1.001f + 0.01f; if (tid == 0 && (spread > sp0_ + 1e-3f || spread < 0.25f * sp0_)) __hip_atomic_fetch_or(F.ctl + CW_PROBE, 2u, RLX_AGENT); }
#else
#define WIN_PROBE(F8_)
#endif
#define DIFF_WINDOW(F8_) \
            const float slope = exp2f(-(float)(h + 1)); const int comp = h * 2 + c; \
            const float qmx = WLD((b * 16 + comp) * 64 + qb), smin = 64.f - WLD(2048 + (b * 16 + comp) * 64 + qb), kmx = WLD(4096 + b * 16 + comp); \
            float qmx_ = qmx, kmx_ = kmx, smin_ = smin, fac_ = F8_ ? 1.258f : 1.f; \
            if (DIFF_LSE_WIN && N_LAUNCHES == 1 && h >= LSE_H0) { const float lmin = WLD(4608 + (b * 16 + comp) * 64 + qb) - 0.125f; \
                if (F8_) { qmx_ = WLD(6656 + (b * 16 + comp) * 64 + qb); kmx_ = WLD(8704 + b * 16 + comp); smin_ = lmin; fac_ = 1.f; } else smin_ = fmaxf(smin_, lmin); }     \
            asm volatile("" : "+v"(qmx_), "+v"(kmx_), "+v"(smin_));     \
              \
            const float spread = (fac_ * qmx_ * kmx_ * att::SCALE - smin_) * 1.001f + 0.01f; \
            const float wf = (spread + __logf(2.f / ((1.f - __expf(-slope)) * 5.9604645e-8f))) / slope; \
            WIN_PROBE(F8_) \
            const int w = wf >= (float)SEQ ? SEQ : (int)wf + 1; \
            const int q0 = qb * 256; \
            int tlo = q0 - w; tlo = tlo < 0 ? 0 : tlo >> 6; int thi = q0 + 256 + w; thi = thi >= SEQ ? SEQ / 64 : (thi + 63) >> 6; \
            if ((thi - tlo) & 1) { if (thi < SEQ / 64) ++thi; else --tlo; } \
            const bf16* base = PROJ1 + (size_t)b * SEQ * L1_IN;
        if (DIFF_F8_HMIN < 8) {
        gu32* head = F.ctl + CW_Q1 + 256 * rep_;
        for (;;) {
            __syncthreads();
            if (tid == 0) F.MISC[16] = __hip_atomic_fetch_add(head, 1u, RLX_AGENT);
            __syncthreads();
            const int u = __builtin_amdgcn_readfirstlane((int)F.MISC[16]);
            if (u >= (8 - DIFF_F8_HMIN) * (DIFF_F8_DV2 ? 256 : 512)) break;
            int h, qb, vh, c, b;
            if (DIFF_F8_DV2) { h = 7 - (u >> 8); qb = u & 63; vh = 0; c = (u >> 6) & 1; b = (u >> 7) & 1; }
            else { h = 7 - (u >> 9); qb = u & 63; vh = (u >> 6) & 1; c = (u >> 7) & 1; b = (u >> 8) & 1; }
            DIFF_WINDOW(true)
            if (DIFF_F8_DV2) att::attn_unit_f8_dv2<1, ATT_SD1F, (DIFF_KIMG != 0)>(base + (size_t)q0 * L1_IN + (h * 2 + c) * HD, L1_IN,
                              DIFF_KIMG ? (const bf16*)(K8D + (size_t)((b * 16 + h * 2 + c) * 256) * 8192) : base + (size_t)(tlo * 64) * L1_IN + 2048 + (h * 2 + c) * HD, L1_IN,
                              V8D + (size_t)(((b * 8 + h) * 2 + 0) * 256) * 8192, V8D + (size_t)(((b * 8 + h) * 2 + 1) * 256) * 8192,
                              OC + (size_t)c * T * DM + ((size_t)b * SEQ + q0) * DM + h * 256, DM, thi - tlo, tlo, (float)(q0 - tlo * 64), slope * (1.0f / att::SCALE), (char*)lds + RING_OFF);
            else att::attn_unit_f8<1, ATT_SD1>(base + (size_t)q0 * L1_IN + (h * 2 + c) * HD, L1_IN, base + (size_t)(tlo * 64) * L1_IN + 2048 + (h * 2 + c) * HD, L1_IN,
                              V8D + (size_t)(((b * 8 + h) * 2 + vh) * 256) * 8192,
                              OC + (size_t)c * T * DM + ((size_t)b * SEQ + q0) * DM + h * 256 + vh * HD, DM, thi - tlo, tlo, (float)(q0 - tlo * 64), slope * (1.0f / att::SCALE), (char*)lds + RING_OFF);
        }
        }
        {
        gu32* head = F.ctl + CW_Q3 + 256 * rep_;
        for (;;) {
            __syncthreads();
            if (tid == 0) F.MISC[16] = __hip_atomic_fetch_add(head, 1u, RLX_AGENT);
            __syncthreads();
            const int u = __builtin_amdgcn_readfirstlane((int)F.MISC[16]);
            if (u >= DIFF_F8_HMIN * 512) break;
            const int h = DIFF_F8_HMIN - 1 - (u >> 9), qb = u & 63, vh = (u >> 6) & 1, c = (u >> 7) & 1, b = (u >> 8) & 1;
            DIFF_WINDOW(false)
            att::attn_unit<1, ATT_SD1, ATT_QK8_DIFF>(base + (size_t)q0 * L1_IN + (h * 2 + c) * HD, L1_IN,
                              base + (size_t)(tlo * 64) * L1_IN + 2048 + (h * 2 + c) * HD, base + (size_t)(tlo * 64) * L1_IN + 4096 + h * 256 + vh * HD, L1_IN,
                              OC + (size_t)c * T * DM + ((size_t)b * SEQ + q0) * DM + h * 256 + vh * HD, DM, nullptr, 0, thi - tlo, (float)(q0 - tlo * 64), slope * (1.0f / att::SCALE), (char*)lds + RING_OFF);
        }
        }
#undef DIFF_WINDOW
#undef WIN_PROBE
#undef WLD
    }
    SEAM(12);
    for (int rep_ = 0; rep_ < (IN(13) ? REPS(13) : 0); ++rep_) {
        PH_BEGIN;
        float lam;
        { const float a = INP(16)[lane] * INP(17)[lane] + INP(16)[lane + 64] * INP(17)[lane + 64], b2 = INP(18)[lane] * INP(19)[lane] + INP(18)[lane + 64] * INP(19)[lane + 64];
          lam = expf(wave_sum(a)) - expf(wave_sum(b2)) + LAMBDA_INIT; }
        for (int t = gw; t < T; t += NGW) {
#pragma unroll
            for (int jj = 0; jj < 4; ++jj) { const int col = 8 * (lane + 64 * jj);
                float a[8], b8[8], v[8]; unpack8(*(const v4u*)(OC + (size_t)t * DM + col), a); unpack8(*(const v4u*)(OC + (size_t)T * DM + (size_t)t * DM + col), b8);
                float ss = 0.f;
#pragma unroll
                for (int i = 0; i < 8; ++i) { v[i] = a[i] - lam * b8[i]; ss += v[i] * v[i]; }
                ss += __shfl_xor(ss, 1); ss += __shfl_xor(ss, 2); ss += __shfl_xor(ss, 4); ss += __shfl_xor(ss, 8); ss += __shfl_xor(ss, 16);
                const float rstd = rsqrtf(ss * (1.f / 256.f) + NORM_EPS) * (1.f - LAMBDA_INIT);
                const f32x4 ga = *(const f32x4*)(INP(20) + (col & 255)), gb = *(const f32x4*)(INP(20) + (col & 255) + 4);
                v[0] *= rstd * ga.x; v[1] *= rstd * ga.y; v[2] *= rstd * ga.z; v[3] *= rstd * ga.w; v[4] *= rstd * gb.x; v[5] *= rstd * gb.y; v[6] *= rstd * gb.z; v[7] *= rstd * gb.w;
                *(v4u*)(H + (size_t)t * DM + col) = pack8(v); }
        }
    }
    SEAM(13);
    for (int rep_ = 0; rep_ < (IN(14) ? REPS(14) : 0); ++rep_) {
        PH_BEGIN;
        pg8::Gemm g{H, W_OUT1, T, DM, DM}; pg8::StaticOrder S; S.init(T, DM, F.G, (int)blockIdx.x);
        pg8::EpiRes E{outp, outp, DM};
        EPI_STAGGER();
        pg8::gemm_phase<pg8::EpiRes, pg8::StaticOrder, true, true>(F.lds + RING_OFF, g, S, E);
    }
    SEAM(14);
    for (int rep_ = 0; rep_ < (IN(15) ? REPS(15) : 0); ++rep_) {
        PH_BEGIN;
        LAS float* WrT = (LAS float*)(F.lds + RING_OFF);
        LAS int* lcnt = (LAS int*)(F.lds + RING_OFF + 65536);
        for (int c = blockIdx.x; c < 256; c += F.G) {
            __syncthreads();
            for (int k = tid; k < DM; k += NWAVES * 64) { const f32x4 w0 = *(const f32x4*)(INP(23) + k * 8), w1 = *(const f32x4*)(INP(23) + k * 8 + 4);
                WrT[0 * DM + k] = w0.x; WrT[1 * DM + k] = w0.y; WrT[2 * DM + k] = w0.z; WrT[3 * DM + k] = w0.w; WrT[4 * DM + k] = w1.x; WrT[5 * DM + k] = w1.y; WrT[6 * DM + k] = w1.z; WrT[7 * DM + k] = w1.w; }
            if (tid < 8) lcnt[tid] = 0;
            __syncthreads();
            const f32x4* gr = (const f32x4*)INP(22) + lane;
#define ROW_LOAD(V_, i_) do { const f32x4* xr_ = (const f32x4*)(outp + (size_t)(c * 128 + (i_)) * DM) + lane; _Pragma("unroll") for (int j = 0; j < 8; ++j) V_[j] = xr_[64 * j]; } while (0)
#define TOP2_OUT(LG_, t_) do { int e0 = 0; float v0 = LG_[0]; \
                _Pragma("unroll") for (int e = 1; e < 8; ++e) if (LG_[e] > v0) { v0 = LG_[e]; e0 = e; } \
                int e1 = -1; float v1 = -3.0e38f; \
                _Pragma("unroll") for (int e = 0; e < 8; ++e) if (e != e0 && LG_[e] > v1) { v1 = LG_[e]; e1 = e; } \
                const float g1 = 1.f / (1.f + expf(v0 - v1)), g0 = 1.f - g1; \
                if (lane == 0) { TOKE[t_] = (i32x2){e0, e1}; TOKG[t_] = (f32x2){g0, g1}; __hip_atomic_fetch_add(lcnt + e0, 1, __ATOMIC_RELAXED, __HIP_MEMORY_SCOPE_WORKGROUP); __hip_atomic_fetch_add(lcnt + e1, 1, __ATOMIC_RELAXED, __HIP_MEMORY_SCOPE_WORKGROUP); } } while (0)
#define PAIR(VA_, VB_, ia_, ib_) do { const int ta = c * 128 + (ia_), tb = c * 128 + (ib_); float sa = 0.f, sb = 0.f; \
                _Pragma("unroll") for (int j = 0; j < 8; ++j) { sa += (VA_[j].x * VA_[j].x + VA_[j].y * VA_[j].y) + (VA_[j].z * VA_[j].z + VA_[j].w * VA_[j].w); sb += (VB_[j].x * VB_[j].x + VB_[j].y * VB_[j].y) + (VB_[j].z * VB_[j].z + VB_[j].w * VB_[j].w); } \
                const float ra = rsqrtf(wave_sum(sa) * (1.f / DM) + NORM_EPS), rb = rsqrtf(wave_sum(sb) * (1.f / DM) + NORM_EPS); \
                unsigned* oa = (unsigned*)(HFB + (size_t)ta * DM) + lane; unsigned* ob = (unsigned*)(HFB + (size_t)tb * DM) + lane; \
                float la[8] = {0.f, 0.f, 0.f, 0.f, 0.f, 0.f, 0.f, 0.f}, lb[8] = {0.f, 0.f, 0.f, 0.f, 0.f, 0.f, 0.f, 0.f}; \
                _Pragma("unroll") for (int j = 0; j < 8; ++j) { const f32x4 gg = gr[64 * j]; f32x4 ha, hb; \
                    ha.x = VA_[j].x * ra * gg.x; ha.y = VA_[j].y * ra * gg.y; ha.z = VA_[j].z * ra * gg.z; ha.w = VA_[j].w * ra * gg.w; \
                    hb.x = VB_[j].x * rb * gg.x; hb.y = VB_[j].y * rb * gg.y; hb.z = VB_[j].z * rb * gg.z; hb.w = VB_[j].w * rb * gg.w; \
                    oa[64 * j] = pk4_fp8(ha.x, ha.y, ha.z, ha.w); ob[64 * j] = pk4_fp8(hb.x, hb.y, hb.z, hb.w); \
                    _Pragma("unroll") for (int e = 0; e < 8; ++e) { const f32x4 wv = *(const LAS f32x4*)(WrT + e * DM + 4 * (lane + 64 * j)); \
                        la[e] += (ha.x * wv.x + ha.y * wv.y) + (ha.z * wv.z + ha.w * wv.w); lb[e] += (hb.x * wv.x + hb.y * wv.y) + (hb.z * wv.z + hb.w * wv.w); } } \
                _Pragma("unroll") for (int e = 0; e < 8; ++e) { la[e] = wave_sum(la[e]); lb[e] = wave_sum(lb[e]); } \
                TOP2_OUT(la, ta); TOP2_OUT(lb, tb); } while (0)
            {
                f32x4 a0[8], b0[8], a1[8], b1[8];
                ROW_LOAD(a0, wave); ROW_LOAD(b0, wave + NWAVES);
#pragma unroll 1
                for (int k = 0; k < 16; k += 4) {
                    ROW_LOAD(a1, wave + NWAVES * (k + 2)); ROW_LOAD(b1, wave + NWAVES * (k + 3));
                    PAIR(a0, b0, wave + NWAVES * k, wave + NWAVES * (k + 1));
                    if (k + 4 < 16) { ROW_LOAD(a0, wave + NWAVES * (k + 4)); ROW_LOAD(b0, wave + NWAVES * (k + 5)); }
                    PAIR(a1, b1, wave + NWAVES * (k + 2), wave + NWAVES * (k + 3));
                }
            }
#undef PAIR
#undef TOP2_OUT
#undef ROW_LOAD
            __syncthreads();
            if (tid < 8) CNT[c * 8 + tid] = lcnt[tid];
        }
    }
    SEAM(15);
    for (int rep_ = 0; rep_ < (IN(16) ? REPS(16) : 0); ++rep_) {
        PH_BEGIN;
        LAS int* tab = (LAS int*)(F.lds + RING_OFF);
        LAS int* bse = tab + 2048;
        LAS int* sel = bse + 8;
        LAS int* dst = sel + 256;
        for (int c = blockIdx.x; c < 256; c += F.G) {
            __syncthreads();
            for (int i = tid; i < 2048; i += NWAVES * 64) tab[i] = CNT[i];
            if (tid < 128) { const i32x2 e = TOKE[c * 128 + tid]; sel[2 * tid] = e.x; sel[2 * tid + 1] = e.y; }
            __syncthreads();
            if (tid < 8) { const int e = tid; int pre = 0, tot = 0;
                for (int cc = 0; cc < 256; ++cc) { const int n = tab[cc * 8 + e]; tot += n; pre += (cc < c) ? n : 0; }
                bse[e] = pre; tab[e] = tot; }
            __syncthreads();
            if (tid < 8) { const int e = tid; int ps = 0;
                for (int k = 0; k < e; ++k) ps += (tab[k] + 255) & ~255;
                int r = ps + bse[e];
                for (int i = 0; i < 256; ++i) if (sel[i] == e) dst[i] = r++;
                if (c == 0) TOT[e] = tab[e]; }
            __syncthreads();
            if (tid < 128) TOKS[c * 128 + tid] = (i32x2){dst[2 * tid], dst[2 * tid + 1]};
            for (int i = wave; i < 128; i += NWAVES) {
                const int t = c * 128 + i; const int s0 = dst[2 * i], s1 = dst[2 * i + 1];
                const v4u* src = (const v4u*)(HFB + (size_t)t * DM) + lane; v4u* d0 = (v4u*)(XS + (size_t)s0 * DM) + lane; v4u* d1 = (v4u*)(XS + (size_t)s1 * DM) + lane;
#pragma unroll
                for (int j = 0; j < 2; ++j) { const v4u w = src[64 * j]; d0[64 * j] = w; d1[64 * j] = w; }
            }
        }
    }
    SEAM(16);
    {
        int cend[8]; int nMt = 0;
        if (IN(17) || IN(18)) {
            PH_BEGIN;
#pragma unroll
            for (int e = 0; e < 8; ++e) { nMt += (__builtin_amdgcn_readfirstlane(__hip_atomic_load((const gu32*)TOT + e, RLX_AGENT)) + 255) >> 8; cend[e] = nMt; }
        }
        for (int rep_ = 0; rep_ < (IN(17) ? REPS(17) : 0); ++rep_) {
            PH_BEGIN;
            pg8::Gemm g{(const bf16*)XS, (const bf16*)W_GUE, nMt * 256, 2 * FFE, DM / 2}; pg8::MoeOrder S; S.init(nMt * 256, 2 * FFE, F.G, (int)blockIdx.x); S.t0 = 0; S.estride = (size_t)2 * FFE * DM;
#pragma unroll
            for (int e = 0; e < 8; ++e) S.cend[e] = cend[e];
            pg8::EpiSwigluF8 E{ACT, FFE, 1.f / SC_WGU, SC_ACT};
            pg8::gemm_phase<pg8::EpiSwigluF8, pg8::MoeOrder, true, true, true>(F.lds + RING_OFF, g, S, E);
        }
        SEAM(17);
        for (int rep_ = 0; rep_ < (IN(18) ? REPS(18) : 0); ++rep_) {
            PH_BEGIN;
            pg8::Gemm g{(const bf16*)ACT, (const bf16*)W_DE, nMt * 256, DM, FFE / 2}; pg8::MoeOrder S; S.init(nMt * 256, DM, F.G, (int)blockIdx.x); S.t0 = 0; S.estride = (size_t)DM * FFE;
#pragma unroll
            for (int e = 0; e < 8; ++e) S.cend[e] = cend[e];
            pg8::EpiBf16 E{Y, DM, 1.f / (SC_ACT * SC_WD)};
            pg8::gemm_phase<pg8::EpiBf16, pg8::MoeOrder, true, true, true>(F.lds + RING_OFF, g, S, E);
        }
        SEAM(18);
    }
    for (int rep_ = 0; rep_ < (IN(19) ? REPS(19) : 0); ++rep_) {
        PH_BEGIN;
#if PROBE_ATT
        const bool probe_bad = __hip_atomic_load(F.ctl + CW_PROBE, RLX_AGENT) != 0u;
#endif
        for (int t = gw; t < T; t += NGW) {
            const i32x2 sl = TOKS[t]; f32x2 gt = TOKG[t];
#if PROBE_ATT
            if (probe_bad) gt.x = __builtin_nanf("");
#endif
            f32x4* xr = (f32x4*)(outp + (size_t)t * DM) + 2 * lane; const v4u* y0 = (const v4u*)(Y + (size_t)sl.x * DM) + lane; const v4u* y1 = (const v4u*)(Y + (size_t)sl.y * DM) + lane;
#pragma unroll
            for (int j = 0; j < 4; ++j) { float a[8], b8[8]; unpack8(y0[64 * j], a); unpack8(y1[64 * j], b8);
                f32x4 x0 = xr[128 * j], x1 = xr[128 * j + 1];
                x0.x += gt.x * a[0] + gt.y * b8[0]; x0.y += gt.x * a[1] + gt.y * b8[1]; x0.z += gt.x * a[2] + gt.y * b8[2]; x0.w += gt.x * a[3] + gt.y * b8[3];
                x1.x += gt.x * a[4] + gt.y * b8[4]; x1.y += gt.x * a[5] + gt.y * b8[5]; x1.z += gt.x * a[6] + gt.y * b8[6]; x1.w += gt.x * a[7] + gt.y * b8[7];
                xr[128 * j] = x0; xr[128 * j + 1] = x1; }
        }
    }
#undef IN
#undef SEAM
#undef GRID_BAR
}

extern "C" void kernel_launch(void* const* d_in, const int* in_sizes, int n_in, void* d_out, int out_size, void* d_ws, size_t ws_size, hipStream_t stream) {
    static int grid = 0;
    if (grid == 0) {
        if (n_in != 27 || in_sizes[0] != T * DM || out_size != T * DM || ws_size < WS_END) { fprintf(stderr, "kernel_launch: shape/workspace mismatch: n_in %d in0 %d out %d ws %zu (need %zu)\n", n_in, n_in > 0 ? in_sizes[0] : -1, out_size, ws_size, (size_t)WS_END); grid = -1; return; }
        int dev = 0, cus = 0, per_cu = 0;
        if (hipGetDevice(&dev) != hipSuccess || hipDeviceGetAttribute(&cus, hipDeviceAttributeMultiprocessorCount, dev) != hipSuccess) { grid = -1; return; }
        if (hipFuncSetAttribute((const void*)mk_fwd, hipFuncAttributeMaxDynamicSharedMemorySize, LDS_BYTES) != hipSuccess) { fprintf(stderr, "kernel_launch: hipFuncSetAttribute failed\n"); grid = -1; return; }
        if (hipOccupancyMaxActiveBlocksPerMultiprocessor(&per_cu, (const void*)mk_fwd, NWAVES * 64, LDS_BYTES) != hipSuccess || per_cu < 1) { fprintf(stderr, "kernel_launch: occupancy query reports %d workgroups per CU\n", per_cu); }
        (void)hipGetLastError();
        grid = cus;
    }
    if (grid < 0) return;
    if (hipMemsetAsync((char*)d_ws + WS_CTL, 0, CTL_ZERO_BYTES, stream) != hipSuccess) return;
    Args a{};
    for (int i = 0; i < 27; ++i) a.in[i] = (const float*)d_in[i];
    a.out = (float*)d_out; a.ws = (unsigned char*)d_ws;
    for (int li = 0; li < N_LAUNCHES; ++li) {
        a.ph_lo = (N_LAUNCHES == 1) ? 0 : li; a.ph_hi = (N_LAUNCHES == 1) ? N_PHASES : li + 1;
        hipLaunchKernelGGL(mk_fwd, dim3(grid), dim3(NWAVES * 64), LDS_BYTES, stream, a);
        const hipError_t le = hipPeekAtLastError();
        if (le != hipSuccess) { fprintf(stderr, "kernel_launch: launch %d failed: %s\n", li, hipGetErrorName(le)); break; }
    }
}
```

```cpp
#include <hip/hip_runtime.h>
#include <cstdio>
#include <cstdint>
namespace pg8 {
#define PG8_LAS __attribute__((address_space(3)))
typedef unsigned short bf16_t;
typedef short bf16x8 __attribute__((ext_vector_type(8)));
typedef float f32x4 __attribute__((ext_vector_type(4)));
typedef unsigned u32x4 __attribute__((ext_vector_type(4)));
typedef int v4i32 __attribute__((ext_vector_type(4)));
typedef int v8i32 __attribute__((ext_vector_type(8)));
constexpr int BM = 256, BK = 64, HALF = 128, HTB = HALF * BK * 2  , STAGE_BYTES = 8 * HTB, NXCD = 8, WGM = 8;

__host__ __device__ __forceinline__ int lds_byte(int r, int c) { const int st = (r >> 4) * 2 + (c >> 5), rr = r & 15, cc = c & 31, ob = rr * 64 + cc * 2; return st * 1024 + (ob ^ (((ob >> 9) & 1) << 5)); }
__host__ __device__ __forceinline__ void stage_rc(int b, int& R, int& C) { const int st = b / 1024, sb = b % 1024, swz = sb ^ (((sb >> 9) & 1) << 5); R = (st >> 1) * 16 + swz / 64; C = (st & 1) * 32 + (swz % 64) / 2; }
__host__ __device__ __forceinline__ int perm32(int rho) { const int n = rho >> 4, i = rho & 15; return 8 * (i >> 2) + 4 * n + (i & 3); }

struct Unit { int pm, pn; };
struct Gemm { const bf16_t* A; const bf16_t* Bt; int M, N, K; };

struct StaticOrder {
    int nM, nN, nwg, G, c;
    __host__ __device__ void init(int M, int N, int G_, int c_) { nM = M / BM; nN = N / BM; nwg = nM * nN; G = G_; c = c_; }
    __host__ __device__ bool next(int i, Unit& u) const {
        const long L = (long)i * G + c; if (L >= nwg) return false;
        int wgid = (int)L; { const int q = nwg / NXCD, r = nwg % NXCD, xcd = wgid % NXCD, off = wgid / NXCD; wgid = (xcd < r ? xcd * (q + 1) : r * (q + 1) + (xcd - r) * q) + off; }
        const int nig = WGM * nN, gid = wgid / nig, fm = gid * WGM, gsz = (nM - fm) < WGM ? (nM - fm) : WGM;
        u.pm = fm + ((wgid % nig) % gsz); u.pn = (wgid % nig) / gsz; return true;
    }
    __device__ __forceinline__ void a_ready(const Unit&) const {}
    __device__ __forceinline__ void done(const Unit&) const {}
    __device__ __forceinline__ size_t b_extra(const Unit&) const { return 0; }
};
struct MoeOrder : StaticOrder {
    int t0; int cend[8]; size_t estride;
    __device__ __forceinline__ size_t b_extra(const Unit& u) const { const int pa = t0 + u.pm; int e = 0;
#pragma unroll
        for (int k = 0; k < 7; ++k) e += (pa >= cend[k]) ? 1 : 0;
        return (size_t)e * estride; }
};

__device__ __forceinline__ unsigned cvt_pk_bf16(float lo, float hi) { unsigned r; asm volatile("v_cvt_pk_bf16_f32 %0, %1, %2" : "=v"(r) : "v"(lo), "v"(hi)); return r; }

struct EpiBf16 {
    static constexpr bool PERM = true, AFTER_DRAIN = false;
    bf16_t* O; int ldc; float scale;
    __device__ __forceinline__ void operator()(const f32x4 (&acc)[2][2][4][2], const Unit& u, int wr, int wc, int fr, int fq) const {
        const int row0 = u.pm * BM + wr * 64 + fr; const int col0 = u.pn * BM + wc * 32 + 8 * fq;
#pragma unroll
        for (int ai = 0; ai < 2; ++ai)
#pragma unroll
            for (int m = 0; m < 4; ++m) { bf16_t* rowp = O + (size_t)(row0 + ai * HALF + m * 16) * ldc + col0;
#pragma unroll
                for (int bj = 0; bj < 2; ++bj) { const f32x4 v0 = acc[ai][bj][m][0] * scale, v1 = acc[ai][bj][m][1] * scale;
                    u32x4 w; w.x = cvt_pk_bf16(v0[0], v0[1]); w.y = cvt_pk_bf16(v0[2], v0[3]); w.z = cvt_pk_bf16(v1[0], v1[1]); w.w = cvt_pk_bf16(v1[2], v1[3]);
                    *(u32x4*)(rowp + bj * HALF) = w; } }
    }
};
__device__ __forceinline__ float silu_mul(float g, float u) { const float e = __builtin_amdgcn_exp2f(g * -1.4426950408889634f); return g * u * __builtin_amdgcn_rcpf(1.0f + e); }
__device__ __forceinline__ float silu_mul_raw(float ag, float au, float c1, float ic2) { const float e = __builtin_amdgcn_exp2f(ag * c1); return (ag * au) * __builtin_amdgcn_rcpf(__builtin_fmaf(e, ic2, ic2)); }
struct EpiSwiglu {
    static constexpr bool PERM = true, AFTER_DRAIN = false;
    bf16_t* O; int ldc; float sin;
    __device__ __forceinline__ void operator()(const f32x4 (&acc)[2][2][4][2], const Unit& u, int wr, int wc, int fr, int fq) const {
        const int row0 = u.pm * BM + wr * 64 + fr; const int col0 = u.pn * HALF + wc * 32 + 8 * fq; const float c1 = sin * -1.4426950408889634f, ic2 = 1.0f / (sin * sin);
#pragma unroll
        for (int ai = 0; ai < 2; ++ai)
#pragma unroll
            for (int m = 0; m < 4; ++m) { bf16_t* rowp = O + (size_t)(row0 + ai * HALF + m * 16) * ldc + col0;
                const f32x4 g0 = acc[ai][0][m][0], g1 = acc[ai][0][m][1], u0 = acc[ai][1][m][0], u1 = acc[ai][1][m][1];
#define SM_(g_, u_) silu_mul_raw(g_, u_, c1, ic2)
                u32x4 w; w.x = cvt_pk_bf16(SM_(g0[0], u0[0]), SM_(g0[1], u0[1])); w.y = cvt_pk_bf16(SM_(g0[2], u0[2]), SM_(g0[3], u0[3]));
                w.z = cvt_pk_bf16(SM_(g1[0], u1[0]), SM_(g1[1], u1[1])); w.w = cvt_pk_bf16(SM_(g1[2], u1[2]), SM_(g1[3], u1[3]));
#undef SM_
                *(u32x4*)rowp = w; }
    }
};
struct EpiRes {
    static constexpr bool PERM = false, AFTER_DRAIN = false;
    const float* base; float* out; int ldc;
    __device__ __forceinline__ void operator()(const f32x4 (&acc)[2][2][4][2], const Unit& u, int wr, int wc, int fr, int fq) const {
        const int col0 = u.pn * BM + wc * 32 + 4 * fq;
        const size_t off0 = (size_t)(u.pm * BM + wr * 64 + fr) * ldc + col0;
        f32x4 h0[16], h1[16];
#define ER_OFF(ai_, m_) (off0 + (size_t)((ai_) * HALF + (m_) * 16) * ldc)
#define ER_LOAD(H_, ai_) do { _Pragma("unroll") for (int m = 0; m < 4; ++m) { const size_t off = ER_OFF(ai_, m); \
            _Pragma("unroll") for (int bj = 0; bj < 2; ++bj) _Pragma("unroll") for (int n = 0; n < 2; ++n) H_[m * 4 + bj * 2 + n] = *(const f32x4*)(base + off + bj * HALF + n * 16); } } while (0)
#define ER_ADD(H_, ai_) do { _Pragma("unroll") for (int m = 0; m < 4; ++m) _Pragma("unroll") for (int bj = 0; bj < 2; ++bj) _Pragma("unroll") for (int n = 0; n < 2; ++n) H_[m * 4 + bj * 2 + n] += acc[ai_][bj][m][n]; } while (0)
#define ER_STORE(H_, ai_) do { _Pragma("unroll") for (int m = 0; m < 4; ++m) { const size_t off = ER_OFF(ai_, m); \
            _Pragma("unroll") for (int bj = 0; bj < 2; ++bj) _Pragma("unroll") for (int n = 0; n < 2; ++n) *(f32x4*)(out + off + bj * HALF + n * 16) = H_[m * 4 + bj * 2 + n]; } } while (0)
        ER_LOAD(h0, 0); asm volatile("" ::: "memory");
        ER_ADD(h0, 0);
#pragma unroll
        for (int i = 0; i < 16; ++i) asm volatile("" : "+v"(h0[i]));
        ER_LOAD(h1, 1); asm volatile("" ::: "memory");
        ER_STORE(h0, 0); asm volatile("" ::: "memory");
        ER_ADD(h1, 1);
        ER_STORE(h1, 1);
#undef ER_STORE
#undef ER_ADD
#undef ER_LOAD
#undef ER_OFF
    }
};

struct EpiSwigluF8 {
    static constexpr bool PERM = true, AFTER_DRAIN = false;
    unsigned char* O; int ldc; float sin, sout;
    __device__ __forceinline__ void operator()(const f32x4 (&acc)[2][2][4][2], const Unit& u, int wr, int wc, int fr, int fq) const {
        const int row0 = u.pm * BM + wr * 64 + fr; const int col0 = u.pn * HALF + wc * 32 + 8 * fq; const float c1 = sin * -1.4426950408889634f, ic2 = 1.0f / (sin * sin * sout);
#pragma unroll
        for (int ai = 0; ai < 2; ++ai)
#pragma unroll
            for (int m = 0; m < 4; ++m) { unsigned char* rowp = O + (size_t)(row0 + ai * HALF + m * 16) * ldc + col0;
                const f32x4 g0 = acc[ai][0][m][0], g1 = acc[ai][0][m][1], u0 = acc[ai][1][m][0], u1 = acc[ai][1][m][1];
                unsigned w0 = 0u, w1 = 0u;
#define SM_(g_, u_) silu_mul_raw(g_, u_, c1, ic2)
                w0 = __builtin_amdgcn_cvt_pk_fp8_f32(SM_(g0[0], u0[0]), SM_(g0[1], u0[1]), w0, false); w0 = __builtin_amdgcn_cvt_pk_fp8_f32(SM_(g0[2], u0[2]), SM_(g0[3], u0[3]), w0, true);
                w1 = __builtin_amdgcn_cvt_pk_fp8_f32(SM_(g1[0], u1[0]), SM_(g1[1], u1[1]), w1, false); w1 = __builtin_amdgcn_cvt_pk_fp8_f32(SM_(g1[2], u1[2]), SM_(g1[3], u1[3]), w1, true);
#undef SM_
                typedef unsigned u32x2 __attribute__((ext_vector_type(2)));
                *(u32x2*)rowp = (u32x2){w0, w1}; }
    }
};

template <class Epi, class Sched, bool ALIGN_EPI = false, bool SP2 = false, bool F8 = false>
__device__ __forceinline__ void gemm_phase(PG8_LAS unsigned char* lds, const Gemm g, const Sched& S, const Epi& E) {
    int tid = threadIdx.x; asm volatile("" : "+v"(tid));
    const int wid = __builtin_amdgcn_readfirstlane(tid >> 6), lane = tid & 63, wr = wid >> 2, wc = wid & 3, fr = lane & 15, fq = lane >> 4;
    const int K = g.K, nt = K / BK;
    unsigned voffA[2], voffB[2];
#pragma unroll
    for (int i = 0; i < 2; ++i) { int R, C; stage_rc(tid * 16 + i * 8192, R, C); const int Rb = Epi::PERM ? ((R & ~31) + perm32(R & 31)) : R;
        voffA[i] = (unsigned)(R * K + C) * 2u; voffB[i] = (unsigned)(Rb * K + C) * 2u; }
    const size_t kstep = (size_t)(BK * 2);
    const size_t hstep = (size_t)HALF * K * 2;
    const size_t tstep = 2 * hstep;
    const unsigned ldsw = (unsigned)wid * 1024u;
    const int aoff = lds_byte(wr * 64 + fr, fq * 8), boff = lds_byte(wc * 32 + fr, fq * 8);
#define PG8_SA(b, h) (((b) * 2 + (h)) * HTB)
#define PG8_SB(b, h) ((4 + (b) * 2 + (h)) * HTB)
#define PG8_STAGE(bufoff, gbase, voff) do { _Pragma("unroll") for (int _i = 0; _i < 2; ++_i) \
        __builtin_amdgcn_global_load_lds((const unsigned*)((const char*)(gbase) + (voff)[_i]), (PG8_LAS unsigned*)(lds + (bufoff) + ldsw + _i * 8192), 16, 0, 0); } while (0)
#define PG8_LDA(dst, b, h) do { _Pragma("unroll") for (int m = 0; m < 4; ++m) _Pragma("unroll") for (int k = 0; k < 2; ++k) dst[m][k] = *(const PG8_LAS bf16x8*)(lds + PG8_SA(b, h) + aoff + m * 2048 + k * 1024); } while (0)
#define PG8_LDB(dst, b, h) do { _Pragma("unroll") for (int n = 0; n < 2; ++n) _Pragma("unroll") for (int k = 0; k < 2; ++k) dst[n][k] = *(const PG8_LAS bf16x8*)(lds + PG8_SB(b, h) + boff + n * 2048 + k * 1024); } while (0)
#define PG8_MMA(ai, bj, At, Bt) do { __builtin_amdgcn_s_setprio(1); \
        if constexpr (F8) { _Pragma("unroll") for (int m = 0; m < 4; ++m) _Pragma("unroll") for (int n = 0; n < 2; ++n) { \
            const v8i32 fb_ = __builtin_shufflevector(__builtin_bit_cast(v4i32, Bt[n][0]), __builtin_bit_cast(v4i32, Bt[n][1]), 0, 1, 2, 3, 4, 5, 6, 7); \
            const v8i32 fa_ = __builtin_shufflevector(__builtin_bit_cast(v4i32, At[m][0]), __builtin_bit_cast(v4i32, At[m][1]), 0, 1, 2, 3, 4, 5, 6, 7); \
            asm volatile("v_mfma_f32_16x16x128_f8f6f4 %0, %1, %2, %0" : "+v"(acc[ai][bj][m][n]) : "v"(fb_), "v"(fa_)); } } \
        else { _Pragma("unroll") for (int m = 0; m < 4; ++m) _Pragma("unroll") for (int n = 0; n < 2; ++n) _Pragma("unroll") for (int k = 0; k < 2; ++k) \
            acc[ai][bj][m][n] = __builtin_amdgcn_mfma_f32_16x16x32_bf16(Bt[n][k], At[m][k], acc[ai][bj][m][n], 0, 0, 0); } \
        __builtin_amdgcn_s_setprio(0); } while (0)
#define PG8_WAIT_V(n) asm volatile("s_waitcnt vmcnt(" #n ")" ::: "memory")
#define PG8_WAIT_L(n) asm volatile("s_waitcnt lgkmcnt(" #n ")" ::: "memory")
#define PG8_BAR __builtin_amdgcn_s_barrier()
#define PG8_SCHED __builtin_amdgcn_sched_barrier(0)
    Unit cur, nxt; int ui = 0;
    if (!S.next(0, cur)) return;
    f32x4 acc[2][2][4][2];
#pragma unroll
    for (int a = 0; a < 2; ++a)
#pragma unroll
        for (int b = 0; b < 2; ++b)
#pragma unroll
            for (int m = 0; m < 4; ++m)
#pragma unroll
                for (int n = 0; n < 2; ++n) acc[a][b][m][n] = (f32x4){0.f, 0.f, 0.f, 0.f};
    bf16x8 At[4][2], B0[2][2], B1[2][2];
    const char* cA = (const char*)g.A + (size_t)cur.pm * tstep; const char* cB = (const char*)g.Bt + S.b_extra(cur) + (size_t)cur.pn * tstep;
    S.a_ready(cur);
    if constexpr (SP2) {
        PG8_STAGE(PG8_SB(0, 0), cB, voffB); PG8_STAGE(PG8_SB(0, 1), cB + hstep, voffB); PG8_STAGE(PG8_SA(0, 0), cA, voffA); PG8_STAGE(PG8_SA(0, 1), cA + hstep, voffA);
        if (wr == 1) PG8_BAR;
        PG8_WAIT_V(2); PG8_BAR;
        PG8_STAGE(PG8_SB(1, 0), cB + kstep, voffB); PG8_STAGE(PG8_SA(1, 0), cA + kstep, voffA); PG8_STAGE(PG8_SB(1, 1), cB + hstep + kstep, voffB);
        PG8_WAIT_V(6); PG8_BAR;
    } else {
        PG8_STAGE(PG8_SB(0, 0), cB, voffB); PG8_STAGE(PG8_SA(0, 0), cA, voffA); PG8_STAGE(PG8_SB(0, 1), cB + hstep, voffB); PG8_STAGE(PG8_SA(0, 1), cA + hstep, voffA);
        if (wr == 1) PG8_BAR;
        PG8_WAIT_V(4); PG8_BAR;
        PG8_STAGE(PG8_SB(1, 0), cB + kstep, voffB); PG8_STAGE(PG8_SA(1, 0), cA + kstep, voffA); PG8_STAGE(PG8_SB(1, 1), cB + hstep + kstep, voffB);
        PG8_WAIT_V(6); PG8_BAR;
    }
    for (;;) {
        const bool has_next = S.next(ui + 1, nxt);
        const char* nA = has_next ? (const char*)g.A + (size_t)nxt.pm * tstep : cA; const char* nB = has_next ? (const char*)g.Bt + S.b_extra(nxt) + (size_t)nxt.pn * tstep : cB;
        for (int t = 0; t < nt; t += 2) {
            const bool last = (t == nt - 2);
            const char* a1 = cA + (size_t)(t + 1) * kstep;
            const char* a2 = last ? nA : cA + (size_t)(t + 2) * kstep; const char* b2 = last ? nB : cB + (size_t)(t + 2) * kstep;
            const char* a3 = a2 + kstep; const char* b3 = b2 + kstep;
            if (last && has_next) S.a_ready(nxt);
            if constexpr (SP2) {
            PG8_LDB(B0, 0, 0); PG8_LDB(B1, 0, 1); PG8_SCHED; PG8_LDA(At, 0, 0); PG8_STAGE(PG8_SA(1, 1), a1 + hstep, voffA);
            PG8_WAIT_V(8); PG8_WAIT_L(0); PG8_BAR; PG8_MMA(0, 0, At, B0); PG8_MMA(0, 1, At, B1); PG8_BAR; PG8_SCHED;
            PG8_LDA(At, 0, 1); PG8_STAGE(PG8_SB(0, 0), b2, voffB); PG8_STAGE(PG8_SB(0, 1), b2 + hstep, voffB); PG8_STAGE(PG8_SA(0, 0), a2, voffA);
            PG8_WAIT_V(8); PG8_WAIT_L(0); PG8_BAR; PG8_MMA(1, 0, At, B0); PG8_MMA(1, 1, At, B1); PG8_BAR; PG8_SCHED;
            PG8_LDB(B0, 1, 0); PG8_LDB(B1, 1, 1); PG8_SCHED; PG8_LDA(At, 1, 0); PG8_STAGE(PG8_SA(0, 1), a2 + hstep, voffA);
            PG8_WAIT_V(8); PG8_WAIT_L(0); PG8_BAR; PG8_MMA(0, 0, At, B0); PG8_MMA(0, 1, At, B1); PG8_BAR; PG8_SCHED;
            PG8_LDA(At, 1, 1); PG8_STAGE(PG8_SB(1, 0), b3, voffB); PG8_STAGE(PG8_SB(1, 1), b3 + hstep, voffB); PG8_STAGE(PG8_SA(1, 0), a3, voffA);
            PG8_WAIT_V(8); PG8_WAIT_L(0); PG8_BAR; PG8_MMA(1, 0, At, B0); PG8_MMA(1, 1, At, B1); PG8_BAR; PG8_SCHED;
            } else {
            PG8_LDB(B0, 0, 0); PG8_SCHED; PG8_LDA(At, 0, 0); PG8_STAGE(PG8_SA(1, 1), a1 + hstep, voffA);
            PG8_WAIT_L(8); PG8_BAR; PG8_WAIT_L(0); PG8_MMA(0, 0, At, B0); PG8_BAR; PG8_SCHED;
            PG8_LDB(B1, 0, 1); PG8_STAGE(PG8_SB(0, 0), b2, voffB);
            PG8_BAR; PG8_WAIT_L(0); PG8_MMA(0, 1, At, B1); PG8_BAR;
            PG8_LDA(At, 0, 1); PG8_STAGE(PG8_SA(0, 0), a2, voffA);
            PG8_BAR; PG8_WAIT_L(0); PG8_MMA(1, 0, At, B0); PG8_BAR; PG8_SCHED;
            PG8_STAGE(PG8_SB(0, 1), b2 + hstep, voffB);
            PG8_WAIT_V(6); PG8_BAR; PG8_MMA(1, 1, At, B1); PG8_BAR;
            PG8_LDB(B0, 1, 0); PG8_SCHED; PG8_LDA(At, 1, 0); PG8_STAGE(PG8_SA(0, 1), a2 + hstep, voffA);
            PG8_WAIT_L(8); PG8_BAR; PG8_WAIT_L(0); PG8_MMA(0, 0, At, B0); PG8_BAR; PG8_SCHED;
            PG8_LDB(B1, 1, 1); PG8_STAGE(PG8_SB(1, 0), b3, voffB);
            PG8_BAR; PG8_WAIT_L(0); PG8_MMA(0, 1, At, B1); PG8_BAR;
            PG8_LDA(At, 1, 1); PG8_STAGE(PG8_SA(1, 0), a3, voffA);
            PG8_BAR; PG8_WAIT_L(0); PG8_MMA(1, 0, At, B0); PG8_BAR; PG8_SCHED;
            PG8_STAGE(PG8_SB(1, 1), b3 + hstep, voffB);
            PG8_WAIT_V(6); PG8_BAR; PG8_MMA(1, 1, At, B1); PG8_BAR;
            }
        }
        if constexpr (ALIGN_EPI) { if (wr == 0) PG8_BAR; }
        if constexpr (F8) asm volatile("s_nop 15\n\ts_nop 15\n\ts_nop 15" ::: "memory");
        if constexpr (!Epi::AFTER_DRAIN) { E(acc, cur, wr, wc, fr, fq); S.done(cur); }
        if (!has_next) break;
#pragma unroll
        for (int a = 0; a < 2; ++a)
#pragma unroll
            for (int b = 0; b < 2; ++b)
#pragma unroll
                for (int m = 0; m < 4; ++m)
#pragma unroll
                    for (int n = 0; n < 2; ++n) acc[a][b][m][n] = (f32x4){0.f, 0.f, 0.f, 0.f};
        cur = nxt; cA = nA; cB = nB; ++ui;
        if constexpr (ALIGN_EPI) { if (wr == 1) PG8_BAR; }
    }
    PG8_WAIT_V(0);
    if constexpr (!ALIGN_EPI) { if (wr == 0) PG8_BAR; }
    PG8_BAR;
    if constexpr (Epi::AFTER_DRAIN) { E.fused(acc, cur, wr, wc, fr, fq, lds, wid, lane); S.done(cur); }
#undef PG8_SA
#undef PG8_SB
#undef PG8_STAGE
#undef PG8_LDA
#undef PG8_LDB
#undef PG8_MMA
#undef PG8_WAIT_V
#undef PG8_WAIT_L
#undef PG8_BAR
#undef PG8_SCHED
}
}
namespace att {
using bf16x8 = __attribute__((ext_vector_type(8))) short;
using s16x4  = __attribute__((ext_vector_type(4))) short;
using f32x16 = __attribute__((ext_vector_type(16))) float;
using u32x4  = __attribute__((ext_vector_type(4))) unsigned;
typedef unsigned short bf16;
constexpr int   D = 128, NW = 8, QBLK = 32, KVBLK = 64;
constexpr float SCALE = 0.088388347648318440f;
constexpr float THR = 8.f;
constexpr size_t SHM_V = KVBLK * D * 2, SHM_K = KVBLK * D * 2, SHM_ATTN = 2 * SHM_V + 2 * SHM_K + NW * 64 * 4;
#define KSWZ(row, colB) ((row) * 256 + ((colB) ^ (((row) & 7) << 4)))
#define SBAR() __builtin_amdgcn_sched_barrier(0)
__device__ __forceinline__ int crow(int r, int hi) { return (r & 3) + 8 * (r >> 2) + 4 * hi; }
__device__ __forceinline__ unsigned cvtpk(float lo, float hi) { unsigned r; asm volatile("v_cvt_pk_bf16_f32 %0, %1, %2" : "=v"(r) : "v"(lo), "v"(hi)); return r; }

__device__ __forceinline__ void partialSM(f32x16& p0, f32x16& p1, float& m_reg, float& mn, float& alpha, const float thr_raw = THR / SCALE, const float padd = 0.f) {
  constexpr float C = SCALE * 1.4426950408889634f;
  float pmax = p0[0];
#pragma unroll
  for (int r = 1; r < 16; ++r) pmax = fmaxf(pmax, p0[r]);
#pragma unroll
  for (int r = 0; r < 16; ++r) pmax = fmaxf(pmax, p1[r]);
  { auto rr = __builtin_amdgcn_permlane32_swap(__float_as_uint(pmax), __float_as_uint(pmax), false, false);
    pmax = fmaxf(__uint_as_float(rr[0]), __uint_as_float(rr[1])); }
  if (__builtin_expect(__all(pmax - m_reg <= thr_raw), 1)) { mn = m_reg; alpha = 1.f; }
  else { mn = fmaxf(m_reg, pmax); alpha = __builtin_amdgcn_exp2f((m_reg - mn) * C); m_reg = mn; }
  const float mnC = -mn * C + padd;
  { typedef float f32x2_ __attribute__((ext_vector_type(2))); const f32x2_ c2 = {C, C}, m2 = {mnC, mnC};
#pragma unroll
    for (int r = 0; r < 16; r += 2) { f32x2_ a = {p0[r], p0[r + 1]}, b = {p1[r], p1[r + 1]}; a = a * c2 + m2; b = b * c2 + m2; p0[r] = a.x; p0[r + 1] = a.y; p1[r] = b.x; p1[r + 1] = b.y; } }
#pragma unroll
  for (int r = 0; r < 16; ++r) p0[r] = __builtin_amdgcn_exp2f(p0[r]);
}
__device__ __forceinline__ void finishSM(f32x16& p0, f32x16& p1, float alpha, float& l_reg, bf16x8& pa0, bf16x8& pa1, bf16x8& pa2, bf16x8& pa3) {
#pragma unroll
  for (int r = 0; r < 16; ++r) p1[r] = __builtin_amdgcn_exp2f(p1[r]);
  float ps;
  { typedef float f32x2_ __attribute__((ext_vector_type(2))); f32x2_ a2 = {p0[0], p0[1]}, b2 = {p1[0], p1[1]};
#pragma unroll
    for (int r = 2; r < 16; r += 2) { a2 += (f32x2_){p0[r], p0[r + 1]}; b2 += (f32x2_){p1[r], p1[r + 1]}; }
    a2 += b2; ps = a2.x + a2.y; }
  { auto rr = __builtin_amdgcn_permlane32_swap(__float_as_uint(ps), __float_as_uint(ps), false, false);
    ps = __uint_as_float(rr[0]) + __uint_as_float(rr[1]); }
  l_reg = l_reg * alpha + ps;
#define PK4(P, BASE, OUT) do { unsigned a0 = cvtpk(P[BASE + 0], P[BASE + 1]), a1 = cvtpk(P[BASE + 2], P[BASE + 3]);   \
    unsigned b0 = cvtpk(P[BASE + 4], P[BASE + 5]), b1 = cvtpk(P[BASE + 6], P[BASE + 7]);                              \
    auto r0 = __builtin_amdgcn_permlane32_swap(a0, b0, false, false); auto r1 = __builtin_amdgcn_permlane32_swap(a1, b1, false, false); \
    u32x4 w = {r0[0], r1[0], r0[1], r1[1]}; OUT = *reinterpret_cast<bf16x8*>(&w); } while (0)
  PK4(p0, 0, pa0); PK4(p0, 8, pa1); PK4(p1, 0, pa2); PK4(p1, 8, pa3);
#undef PK4
}
template <int MODE>
__device__ __forceinline__ void qkt(f32x16& p0, f32x16& p1, const char* Ks, const bf16x8* qr, int r32, int hi, float dq, float slopeS) {
  if constexpr (MODE == 0) { p0 = f32x16{}; p1 = f32x16{}; }
  else {
#pragma unroll
    for (int r = 0; r < 16; ++r) { const float d0 = dq - (float)((r & 3) + 8 * (r >> 2)), d1 = d0 - 32.f;
      p0[r] = __builtin_fabsf(d0) * -slopeS; p1[r] = __builtin_fabsf(d1) * -slopeS;
      if constexpr (MODE == 2) { if (__builtin_fabsf(d0) > 64.f) p0[r] = -__builtin_inff(); if (__builtin_fabsf(d1) > 64.f) p1[r] = -__builtin_inff(); } }
  }
#pragma unroll
  for (int d0 = 0; d0 < 8; ++d0) { const int cb = (d0 * 16 + hi * 8) * 2;
    bf16x8 b0 = *reinterpret_cast<const bf16x8*>(Ks + KSWZ(r32, cb));
    bf16x8 b1 = *reinterpret_cast<const bf16x8*>(Ks + KSWZ(32 + r32, cb));
    p0 = __builtin_amdgcn_mfma_f32_32x32x16_bf16(b0, qr[d0], p0, 0, 0, 0);
    p1 = __builtin_amdgcn_mfma_f32_32x32x16_bf16(b1, qr[d0], p1, 0, 0, 0); }
}
typedef int v4i32 __attribute__((ext_vector_type(4)));
typedef int v8i32 __attribute__((ext_vector_type(8)));
#define K8OFF(row, c) ((row) * 128 + ((((c)) ^ (((row) >> 1) & 7)) << 4))
__device__ __forceinline__ int k8off(int row, int c) { return K8OFF(row, c); }
__device__ __forceinline__ unsigned pk4f8(float a, float b, float c, float d) { unsigned w = 0u; w = __builtin_amdgcn_cvt_pk_fp8_f32(a, b, w, false); w = __builtin_amdgcn_cvt_pk_fp8_f32(c, d, w, true); return w; }
__device__ __forceinline__ float bfl(unsigned w) { return __uint_as_float(w << 16); }
__device__ __forceinline__ float bfh(unsigned w) { return __uint_as_float(w & 0xffff0000u); }
__device__ __forceinline__ void bf8_to_f8(const bf16x8 x, unsigned& lo, unsigned& hi) {
  const u32x4 w = __builtin_bit_cast(u32x4, x); lo = pk4f8(bfl(w.x), bfh(w.x), bfl(w.y), bfh(w.y)); hi = pk4f8(bfl(w.z), bfh(w.z), bfl(w.w), bfh(w.w)); }
template <int MODE>
__device__ __forceinline__ void qkt8(f32x16& p0, f32x16& p1, const char* Ks, const v8i32* q8, int r32, int hi, float dq, float slopeS) {
  if constexpr (MODE == 0) { p0 = f32x16{}; p1 = f32x16{}; }
  else {
#pragma unroll
    for (int r = 0; r < 16; ++r) { const float d0 = dq - (float)((r & 3) + 8 * (r >> 2)), d1 = d0 - 32.f;
      p0[r] = __builtin_fabsf(d0) * -slopeS; p1[r] = __builtin_fabsf(d1) * -slopeS;
      if constexpr (MODE == 2) { if (__builtin_fabsf(d0) > 64.f) p0[r] = -__builtin_inff(); if (__builtin_fabsf(d1) > 64.f) p1[r] = -__builtin_inff(); } }
  }
#pragma unroll
  for (int m = 0; m < 2; ++m) { const int c0 = 4 * m + 2 * hi;
    const v4i32 a0l = *reinterpret_cast<const v4i32*>(Ks + K8OFF(r32, c0)), a0h = *reinterpret_cast<const v4i32*>(Ks + K8OFF(r32, c0 + 1));
    const v4i32 a1l = *reinterpret_cast<const v4i32*>(Ks + K8OFF(32 + r32, c0)), a1h = *reinterpret_cast<const v4i32*>(Ks + K8OFF(32 + r32, c0 + 1));
    const v8i32 a0 = __builtin_shufflevector(a0l, a0h, 0, 1, 2, 3, 4, 5, 6, 7), a1 = __builtin_shufflevector(a1l, a1h, 0, 1, 2, 3, 4, 5, 6, 7);
    p0 = __builtin_amdgcn_mfma_scale_f32_32x32x64_f8f6f4(a0, q8[m], p0, 0, 0, 0, 0, 0, 0);
    p1 = __builtin_amdgcn_mfma_scale_f32_32x32x64_f8f6f4(a1, q8[m], p1, 0, 0, 0, 0, 0, 0); }
}
__device__ __forceinline__ int v_st(int k, int c) { const int kk = (k & ~0xC) | ((k & 4) << 1) | ((k & 8) >> 1); return ((kk >> 3) * 4 + (c >> 5)) * 512 + ((kk & 7) * 32 + (c & 31)) * 2; }
__device__ __forceinline__ int v_rd_base(int lane) { return ((lane & 3) << 3) | (((lane >> 2) & 3) << 6) | (((lane >> 4) & 1) << 5) | (((lane >> 5) & 1) << 8); }
constexpr int v_rd_off(int d0, int ks, int half) { return d0 * 512 + ks * 4096 + half * 2048; }
template <int OFF> __device__ __forceinline__ s16x4 tr_read(int vb) {
  s16x4 r; asm volatile("ds_read_b64_tr_b16 %0, %1 offset:%2" : "=&v"(r) : "v"(vb), "i"(OFF) : "memory"); return r;
}
template <int D0> __device__ __forceinline__ void pv_one(f32x16& od, int vb, bf16x8 pa0, bf16x8 pa1, bf16x8 pa2, bf16x8 pa3) {
  const s16x4 l0 = tr_read<v_rd_off(D0, 0, 0)>(vb), h0 = tr_read<v_rd_off(D0, 0, 1)>(vb), l1 = tr_read<v_rd_off(D0, 1, 0)>(vb), h1 = tr_read<v_rd_off(D0, 1, 1)>(vb);
  const s16x4 l2 = tr_read<v_rd_off(D0, 2, 0)>(vb), h2 = tr_read<v_rd_off(D0, 2, 1)>(vb), l3 = tr_read<v_rd_off(D0, 3, 0)>(vb), h3 = tr_read<v_rd_off(D0, 3, 1)>(vb);
  asm volatile("s_waitcnt lgkmcnt(0)" ::: "memory"); SBAR();
#define PK(L, H) (bf16x8){L[0], L[1], L[2], L[3], H[0], H[1], H[2], H[3]}
  od = __builtin_amdgcn_mfma_f32_32x32x16_bf16(pa0, PK(l0, h0), od, 0, 0, 0);
  od = __builtin_amdgcn_mfma_f32_32x32x16_bf16(pa1, PK(l1, h1), od, 0, 0, 0);
  od = __builtin_amdgcn_mfma_f32_32x32x16_bf16(pa2, PK(l2, h2), od, 0, 0, 0);
  od = __builtin_amdgcn_mfma_f32_32x32x16_bf16(pa3, PK(l3, h3), od, 0, 0, 0);
#undef PK
}
__device__ __forceinline__ void pv_d0(f32x16* o, int vb, bf16x8 pa0, bf16x8 pa1, bf16x8 pa2, bf16x8 pa3) {
  pv_one<0>(o[0], vb, pa0, pa1, pa2, pa3); pv_one<1>(o[1], vb, pa0, pa1, pa2, pa3); pv_one<2>(o[2], vb, pa0, pa1, pa2, pa3); pv_one<3>(o[3], vb, pa0, pa1, pa2, pa3);
}

template <int MODE, int SD, int QK8 = 0>
__device__ __forceinline__ void attn_unit(const bf16* __restrict__ Qb, int ldq, const bf16* __restrict__ Kh, const bf16* __restrict__ Vh, int ldk,
                                          bf16* __restrict__ Ob, int ldo_, float* __restrict__ lse_out, int lse_stride_, int NT, float dq0, float slopeS, char* lds) {
  constexpr bool NOPV = (MODE == 3);
  int tid = threadIdx.x; asm volatile("" : "+v"(tid));
  const int wid = __builtin_amdgcn_readfirstlane(tid >> 6), lane = tid & 63, r32 = lane & 31, hi = lane >> 5;
  char* V_lds = lds; char* K_lds = lds + 2 * SHM_V;
  float* ws = (float*)(lds + 2 * SHM_V + 2 * SHM_K) + wid * 64; float* li_l = ws; float* al_l = ws + 32;
  float m_reg = -1e30f, l_reg = 0; f32x16 o[4] = {}; bf16x8 qr[8];
  const bf16* Qw = Qb + (unsigned)((wid * QBLK + r32) * ldq + hi * 8);
  v8i32 q8[2];
  if constexpr (QK8) {
    const bf16* Q8 = Qb + (unsigned)((wid * QBLK + r32) * ldq + hi * 32);
#pragma unroll
    for (int m = 0; m < 2; ++m) { unsigned w[8];
#pragma unroll
      for (int c = 0; c < 4; ++c) bf8_to_f8(*reinterpret_cast<const bf16x8*>(Q8 + m * 64 + c * 8), w[2 * c], w[2 * c + 1]);
      q8[m] = (v8i32){(int)w[0], (int)w[1], (int)w[2], (int)w[3], (int)w[4], (int)w[5], (int)w[6], (int)w[7]}; }
  } else {
#pragma unroll
    for (int d0 = 0; d0 < 8; ++d0) qr[d0] = *reinterpret_cast<const bf16x8*>(Qw + d0 * 16);
  }
  const int sr = tid >> 4, sc = (tid & 15) * 8, vst0 = v_st(sr, sc), vst1 = v_st(32 + sr, sc);
  const int vb0 = (int)(uintptr_t)V_lds + v_rd_base(lane);
  const float dqb = dq0 + (float)(wid * QBLK + r32 - 4 * hi);
  struct { bf16x8 vs0, vs1, ks0, ks1; } sr_[SD];
#define SLOAD(i, k0) do { if constexpr (!NOPV) { sr_[i].vs0 = *reinterpret_cast<const bf16x8*>(&Vh[(unsigned)(((k0) + sr) * ldk + sc)]); sr_[i].vs1 = *reinterpret_cast<const bf16x8*>(&Vh[(unsigned)(((k0) + 32 + sr) * ldk + sc)]); } \
    sr_[i].ks0 = *reinterpret_cast<const bf16x8*>(&Kh[(unsigned)(((k0) + sr) * ldk + sc)]); sr_[i].ks1 = *reinterpret_cast<const bf16x8*>(&Kh[(unsigned)(((k0) + 32 + sr) * ldk + sc)]); } while (0)
#define SWRITE(b, i) do { if constexpr (!NOPV) { *(bf16x8*)(V_lds + (b) * SHM_V + vst0) = sr_[i].vs0;          \
    *(bf16x8*)(V_lds + (b) * SHM_V + vst1) = sr_[i].vs1; } const int kc = sc * 2;               \
    if constexpr (QK8) { typedef unsigned u32x2_ __attribute__((ext_vector_type(2))); unsigned l0_, h0_, l1_, h1_; bf8_to_f8(sr_[i].ks0, l0_, h0_); bf8_to_f8(sr_[i].ks1, l1_, h1_); \
      *(u32x2_*)(K_lds + (b) * SHM_K + K8OFF(sr, sc >> 4) + ((sc >> 3) & 1) * 8) = (u32x2_){l0_, h0_}; *(u32x2_*)(K_lds + (b) * SHM_K + K8OFF(32 + sr, sc >> 4) + ((sc >> 3) & 1) * 8) = (u32x2_){l1_, h1_}; } \
    else { *(bf16x8*)(K_lds + (b) * SHM_K + KSWZ(sr, kc)) = sr_[i].ks0;                       \
    *(bf16x8*)(K_lds + (b) * SHM_K + KSWZ(32 + sr, kc)) = sr_[i].ks1; } } while (0)
#define QKT(P0_, P1_, KS_, DQ_) do { if constexpr (QK8) qkt8<MODE>(P0_, P1_, KS_, q8, r32, hi, DQ_, slopeS); else qkt<MODE>(P0_, P1_, KS_, qr, r32, hi, DQ_, slopeS); } while (0)
#define SWAIT() do { if constexpr (SD == 2 && !NOPV) asm volatile("s_waitcnt vmcnt(4)" ::: "memory"); else if constexpr (SD == 2) asm volatile("s_waitcnt vmcnt(2)" ::: "memory"); else asm volatile("s_waitcnt vmcnt(0)" ::: "memory"); } while (0)
#define RESC(a) do { if constexpr (!NOPV) if (__any((a) < 1.f)) { if (hi == 0) al_l[r32] = (a); asm volatile("s_waitcnt lgkmcnt(0)" ::: "memory"); \
    _Pragma("unroll") for (int d = 0; d < 4; ++d) _Pragma("unroll") for (int r = 0; r < 16; ++r) o[d][r] *= al_l[crow(r, hi)]; } } while (0)
  f32x16 pA0, pA1, pB0, pB1; float mnA, mnB, alA, alB; bf16x8 pa0, pa1, pa2, pa3;
  constexpr int SE = 0, SO = SD - 1;
  SLOAD(SE, 0); asm volatile("s_waitcnt vmcnt(0)" ::: "memory"); SWRITE(0, SE); __syncthreads();
  QKT(pA0, pA1, K_lds, dqb); partialSM(pA0, pA1, m_reg, mnA, alA);
  SLOAD(SO, KVBLK); if constexpr (SD == 2) { if (2 < NT) SLOAD(SE, 2 * KVBLK); }
  SWAIT(); SWRITE(1, SO); __syncthreads();
  for (int j = 1; j + 1 < NT; j += 2) {
    SBAR(); QKT(pB0, pB1, K_lds + SHM_K, dqb - (float)(j * KVBLK));
    finishSM(pA0, pA1, alA, l_reg, pa0, pa1, pa2, pa3); SBAR();
    SLOAD(SO, (j + SD) * KVBLK); SBAR();
    if constexpr (!NOPV) pv_d0(o, vb0, pa0, pa1, pa2, pa3); partialSM(pB0, pB1, m_reg, mnB, alB);
    __syncthreads(); SWAIT(); SWRITE(0, SE);
    RESC(alB); __syncthreads();
    SBAR(); QKT(pA0, pA1, K_lds, dqb - (float)((j + 1) * KVBLK));
    finishSM(pB0, pB1, alB, l_reg, pa0, pa1, pa2, pa3); SBAR();
    if (SD == 1 || j + 3 < NT) SLOAD(SE, (j + 1 + SD) * KVBLK); SBAR();
    if constexpr (!NOPV) pv_d0(o, vb0 + (int)SHM_V, pa0, pa1, pa2, pa3); partialSM(pA0, pA1, m_reg, mnA, alA);
    __syncthreads(); SWAIT(); SWRITE(1, SO);
    RESC(alA); __syncthreads();
  }
  SBAR(); QKT(pB0, pB1, K_lds + SHM_K, dqb - (float)((NT - 1) * KVBLK));
  finishSM(pA0, pA1, alA, l_reg, pa0, pa1, pa2, pa3); SBAR();
  if constexpr (!NOPV) pv_d0(o, vb0, pa0, pa1, pa2, pa3); partialSM(pB0, pB1, m_reg, mnB, alB);
  __syncthreads(); RESC(alB);
  finishSM(pB0, pB1, alB, l_reg, pa0, pa1, pa2, pa3); SBAR();
  if constexpr (!NOPV) pv_d0(o, vb0 + (int)SHM_V, pa0, pa1, pa2, pa3);
  if constexpr (!NOPV) {
  if (hi == 0) li_l[r32] = l_reg; asm volatile("s_waitcnt lgkmcnt(0)" ::: "memory");
  float rli[16];
#pragma unroll
  for (int r = 0; r < 16; ++r) rli[r] = __builtin_amdgcn_rcpf(li_l[crow(r, hi)]);
  int ldo = ldo_; asm volatile("" : "+s"(ldo));
  bf16* Ow = Ob + (unsigned)((wid * QBLK) * ldo);
#pragma unroll
  for (int r = 0; r < 16; ++r) { const int orow = crow(r, hi);
#pragma unroll
    for (int d0 = 0; d0 < 4; ++d0) { const float v = o[d0][r] * rli[r]; unsigned u = __builtin_bit_cast(unsigned, v); u = (u + 0x7fffu + ((u >> 16) & 1u)) >> 16; Ow[(unsigned)(orow * ldo + d0 * 32 + r32)] = (bf16)u; } }
  }
  if constexpr (MODE == 2 || MODE == 3) { int lse_stride = lse_stride_; asm volatile("" : "+s"(lse_stride)); if (hi == 0) lse_out[(unsigned)((wid * QBLK + r32) * lse_stride)] = m_reg * SCALE + __logf(l_reg); }
#undef QKT
#undef SLOAD
#undef SWRITE
#undef SWAIT
#undef RESC
}

__device__ __forceinline__ bf16x8 round_f8(const bf16x8 x, float& n2) {
  typedef float f32x2_ __attribute__((ext_vector_type(2)));
  unsigned lo, hi; bf8_to_f8(x, lo, hi);
  const f32x2_ a = __builtin_amdgcn_cvt_pk_f32_fp8((int)lo, false), b = __builtin_amdgcn_cvt_pk_f32_fp8((int)lo, true), c = __builtin_amdgcn_cvt_pk_f32_fp8((int)hi, false), d = __builtin_amdgcn_cvt_pk_f32_fp8((int)hi, true);
  n2 += a.x * a.x + a.y * a.y + b.x * b.x + b.y * b.y + c.x * c.x + c.y * c.y + d.x * d.x + d.y * d.y;
  const u32x4 w = {(__float_as_uint(a.x) >> 16) | (__float_as_uint(a.y) & 0xffff0000u), (__float_as_uint(b.x) >> 16) | (__float_as_uint(b.y) & 0xffff0000u),
                   (__float_as_uint(c.x) >> 16) | (__float_as_uint(c.y) & 0xffff0000u), (__float_as_uint(d.x) >> 16) | (__float_as_uint(d.y) & 0xffff0000u)};
  return __builtin_bit_cast(bf16x8, w);
}
__device__ __forceinline__ float lse_block(const bf16x8 (&ks)[8], const bf16x8 (&qr)[8], float slopeS, char* lds) {
  int tid = threadIdx.x; asm volatile("" : "+v"(tid));
  const int wid = __builtin_amdgcn_readfirstlane(tid >> 6), lane = tid & 63, r32 = lane & 31, hi = lane >> 5;
  const int sr = tid >> 4, kc = (tid & 15) * 16;
#pragma unroll
  for (int i = 0; i < 8; ++i) *(bf16x8*)(lds + (i >> 1) * SHM_K + KSWZ((i & 1) * 32 + sr, kc)) = ks[i];
  __syncthreads();
  const float dqb = (float)(wid * QBLK + r32 - 4 * hi);
  float m_reg = -1e30f, l_reg = 0.f;
#pragma unroll 1
  for (int t = 0; t < 4; ++t) {
    f32x16 p0, p1; float mn, al;
    qkt<1>(p0, p1, lds + t * SHM_K, qr, r32, hi, dqb - (float)(t * KVBLK), slopeS);
    partialSM(p0, p1, m_reg, mn, al);
    float ps = 0.f;
#pragma unroll
    for (int r = 0; r < 16; ++r) ps += p0[r] + __builtin_amdgcn_exp2f(p1[r]);
    { auto rr = __builtin_amdgcn_permlane32_swap(__float_as_uint(ps), __float_as_uint(ps), false, false);
      ps = __uint_as_float(rr[0]) + __uint_as_float(rr[1]); }
    l_reg = l_reg * al + ps;
  }
  return m_reg * SCALE + __logf(l_reg);
}

constexpr float THR8 = 3.0f, PSC = 16.f, PSC_LOG2 = 4.f;
__device__ __forceinline__ void finishSM8(f32x16& p0, f32x16& p1, float alpha, float& l_reg, v8i32& pa) {
#pragma unroll
  for (int r = 0; r < 16; ++r) p1[r] = __builtin_amdgcn_exp2f(p1[r]);
  float ps;
  { typedef float f32x2_ __attribute__((ext_vector_type(2))); f32x2_ a2 = {p0[0], p0[1]}, b2 = {p1[0], p1[1]};
#pragma unroll
    for (int r = 2; r < 16; r += 2) { a2 += (f32x2_){p0[r], p0[r + 1]}; b2 += (f32x2_){p1[r], p1[r + 1]}; }
    a2 += b2; ps = a2.x + a2.y; }
  { auto rr = __builtin_amdgcn_permlane32_swap(__float_as_uint(ps), __float_as_uint(ps), false, false);
    ps = __uint_as_float(rr[0]) + __uint_as_float(rr[1]); }
  l_reg = l_reg * alpha + ps;
  unsigned w[8];
#pragma unroll
  for (int g = 0; g < 4; ++g) { w[g] = pk4f8(p0[4 * g], p0[4 * g + 1], p0[4 * g + 2], p0[4 * g + 3]); w[4 + g] = pk4f8(p1[4 * g], p1[4 * g + 1], p1[4 * g + 2], p1[4 * g + 3]); }
  pa = (v8i32){(int)w[0], (int)w[1], (int)w[2], (int)w[3], (int)w[4], (int)w[5], (int)w[6], (int)w[7]};
}
__device__ __forceinline__ void pv8(f32x16* o, const char* Vs, const v8i32 pa, int r32, int hi) {
  const int sw = (r32 >> 2) & 3;
#pragma unroll
  for (int d0 = 0; d0 < 4; ++d0) { const char* p = Vs + (32 * d0 + r32) * 64;
    const v4i32 lo = *reinterpret_cast<const v4i32*>(p + (((2 * hi) ^ sw) << 4)), hh = *reinterpret_cast<const v4i32*>(p + (((2 * hi + 1) ^ sw) << 4));
    const v8i32 f = __builtin_shufflevector(lo, hh, 0, 1, 2, 3, 4, 5, 6, 7);
    o[d0] = __builtin_amdgcn_mfma_scale_f32_32x32x64_f8f6f4(pa, f, o[d0], 0, 0, 0, 0, 0, 0); }
}
template <int MODE, int SD, bool KIMG = false>
__device__ __forceinline__ void attn_unit_f8(const bf16* __restrict__ Qb, int ldq, const bf16* __restrict__ Kh, int ldk, const unsigned char* __restrict__ V8,
                                             bf16* __restrict__ Ob, int ldo_, int NT, int t0, float dq0, float slopeS, char* lds) {
  int tid = threadIdx.x; asm volatile("" : "+v"(tid));
  const int wid = __builtin_amdgcn_readfirstlane(tid >> 6), lane = tid & 63, r32 = lane & 31, hi = lane >> 5;
  char* V_lds = lds; char* K_lds = lds + 2 * SHM_V;
  float* ws = (float*)(lds + 2 * SHM_V + 2 * SHM_K) + wid * 64; float* li_l = ws; float* al_l = ws + 32;
  float m_reg = -1e30f, l_reg = 0; f32x16 o[4] = {};
  v8i32 q8[2];
  { const bf16* Q8 = Qb + (unsigned)((wid * QBLK + r32) * ldq + hi * 32);
#pragma unroll
    for (int m = 0; m < 2; ++m) { unsigned w[8];
#pragma unroll
      for (int c = 0; c < 4; ++c) bf8_to_f8(*reinterpret_cast<const bf16x8*>(Q8 + m * 64 + c * 8), w[2 * c], w[2 * c + 1]);
      q8[m] = (v8i32){(int)w[0], (int)w[1], (int)w[2], (int)w[3], (int)w[4], (int)w[5], (int)w[6], (int)w[7]}; } }
  const int sr = tid >> 4, sc = (tid & 15) * 8;
  const float dqb = dq0 + (float)(wid * QBLK + r32 - 4 * hi);
  struct { bf16x8 ks0, ks1; u32x4 v; } sr_[SD];
#define SLOAD(i, t_) do { const unsigned io_ = (unsigned)((t0 + (t_)) * 8192 + tid * 16); sr_[i].v = *reinterpret_cast<const u32x4*>(V8 + io_); \
    if constexpr (KIMG) sr_[i].ks0 = *reinterpret_cast<const bf16x8*>((const unsigned char*)Kh + io_); \
    else { sr_[i].ks0 = *reinterpret_cast<const bf16x8*>(&Kh[(unsigned)(((t_) * KVBLK + sr) * ldk + sc)]); sr_[i].ks1 = *reinterpret_cast<const bf16x8*>(&Kh[(unsigned)(((t_) * KVBLK + 32 + sr) * ldk + sc)]); } } while (0)
#define SWRITE(b, i) do { *(u32x4*)(V_lds + (b) * SHM_V + tid * 16) = sr_[i].v; \
    if constexpr (KIMG) *(bf16x8*)(K_lds + (b) * SHM_K + tid * 16) = sr_[i].ks0; \
    else { typedef unsigned u32x2_ __attribute__((ext_vector_type(2))); unsigned l0_, h0_, l1_, h1_; bf8_to_f8(sr_[i].ks0, l0_, h0_); bf8_to_f8(sr_[i].ks1, l1_, h1_); \
    *(u32x2_*)(K_lds + (b) * SHM_K + K8OFF(sr, sc >> 4) + ((sc >> 3) & 1) * 8) = (u32x2_){l0_, h0_}; *(u32x2_*)(K_lds + (b) * SHM_K + K8OFF(32 + sr, sc >> 4) + ((sc >> 3) & 1) * 8) = (u32x2_){l1_, h1_}; } } while (0)
#define SWAIT() do { if constexpr (SD == 2) asm volatile("s_waitcnt vmcnt(%0)" :: "n"(KIMG ? 2 : 3) : "memory"); else asm volatile("s_waitcnt vmcnt(0)" ::: "memory"); } while (0)
#define RESC(a) do { if (__any((a) < 1.f)) { if (hi == 0) al_l[r32] = (a); asm volatile("s_waitcnt lgkmcnt(0)" ::: "memory"); \
    _Pragma("unroll") for (int d = 0; d < 4; ++d) _Pragma("unroll") for (int r = 0; r < 16; ++r) o[d][r] *= al_l[crow(r, hi)]; } } while (0)
  f32x16 pA0, pA1, pB0, pB1; float mnA, mnB, alA, alB; v8i32 pa;
  constexpr int SE = 0, SO = SD - 1; constexpr float TR = THR8 / SCALE;
  SLOAD(SE, 0); asm volatile("s_waitcnt vmcnt(0)" ::: "memory"); SWRITE(0, SE); __syncthreads();
  qkt8<MODE>(pA0, pA1, K_lds, q8, r32, hi, dqb, slopeS); partialSM(pA0, pA1, m_reg, mnA, alA, TR, PSC_LOG2);
  SLOAD(SO, 1); if constexpr (SD == 2) { if (2 < NT) SLOAD(SE, 2); }
  SWAIT(); SWRITE(1, SO); __syncthreads();
  for (int j = 1; j + 1 < NT; j += 2) {
    SBAR(); qkt8<MODE>(pB0, pB1, K_lds + SHM_K, q8, r32, hi, dqb - (float)(j * KVBLK), slopeS);
    finishSM8(pA0, pA1, alA, l_reg, pa); SBAR();
    SLOAD(SO, j + SD); SBAR();
    pv8(o, V_lds, pa, r32, hi); partialSM(pB0, pB1, m_reg, mnB, alB, TR, PSC_LOG2);
    __syncthreads(); SWAIT(); SWRITE(0, SE);
    RESC(alB); __syncthreads();
    SBAR(); qkt8<MODE>(pA0, pA1, K_lds, q8, r32, hi, dqb - (float)((j + 1) * KVBLK), slopeS);
    finishSM8(pB0, pB1, alB, l_reg, pa); SBAR();
    if (SD == 1 || j + 3 < NT) SLOAD(SE, j + 1 + SD); SBAR();
    pv8(o, V_lds + SHM_V, pa, r32, hi); partialSM(pA0, pA1, m_reg, mnA, alA, TR, PSC_LOG2);
    __syncthreads(); SWAIT(); SWRITE(1, SO);
    RESC(alA); __syncthreads();
  }
  SBAR(); qkt8<MODE>(pB0, pB1, K_lds + SHM_K, q8, r32, hi, dqb - (float)((NT - 1) * KVBLK), slopeS);
  finishSM8(pA0, pA1, alA, l_reg, pa); SBAR();
  pv8(o, V_lds, pa, r32, hi); partialSM(pB0, pB1, m_reg, mnB, alB, TR, PSC_LOG2);
  __syncthreads(); RESC(alB);
  finishSM8(pB0, pB1, alB, l_reg, pa); SBAR();
  pv8(o, V_lds + SHM_V, pa, r32, hi);
  if (hi == 0) li_l[r32] = l_reg; asm volatile("s_waitcnt lgkmcnt(0)" ::: "memory");
  float rli[16];
#pragma unroll
  for (int r = 0; r < 16; ++r) rli[r] = __builtin_amdgcn_rcpf(li_l[crow(r, hi)]);
  int ldo = ldo_; asm volatile("" : "+s"(ldo));
  bf16* Ow = Ob + (unsigned)((wid * QBLK) * ldo);
#pragma unroll
  for (int r = 0; r < 16; ++r) { const int orow = crow(r, hi);
#pragma unroll
    for (int d0 = 0; d0 < 4; ++d0) { const float v = o[d0][r] * rli[r]; unsigned u = __builtin_bit_cast(unsigned, v); u = (u + 0x7fffu + ((u >> 16) & 1u)) >> 16; Ow[(unsigned)(orow * ldo + d0 * 32 + r32)] = (bf16)u; } }
#undef SLOAD
#undef SWRITE
#undef SWAIT
#undef RESC
}
template <int MODE, int SD, bool KIMG = false>
__device__ __forceinline__ void attn_unit_f8_dv2(const bf16* __restrict__ Qb, int ldq, const bf16* __restrict__ Kh, int ldk, const unsigned char* __restrict__ V8a, const unsigned char* __restrict__ V8b,
                                                 bf16* __restrict__ Ob, int ldo_, int NT, int t0, float dq0, float slopeS, char* lds) {
  int tid = threadIdx.x; asm volatile("" : "+v"(tid));
  const int wid = __builtin_amdgcn_readfirstlane(tid >> 6), lane = tid & 63, r32 = lane & 31, hi = lane >> 5;
  char* V_lds = lds; char* K_lds = lds + 2 * SHM_V;
  float* ws = (float*)(lds + 2 * SHM_V + 2 * SHM_K) + wid * 64; float* li_l = ws; float* al_l = ws + 32;
  float m_reg = -1e30f, l_reg = 0; f32x16 o[8] = {};
  v8i32 q8[2];
  { const bf16* Q8 = Qb + (unsigned)((wid * QBLK + r32) * ldq + hi * 32);
#pragma unroll
    for (int m = 0; m < 2; ++m) { unsigned w[8];
#pragma unroll
      for (int c = 0; c < 4; ++c) bf8_to_f8(*reinterpret_cast<const bf16x8*>(Q8 + m * 64 + c * 8), w[2 * c], w[2 * c + 1]);
      q8[m] = (v8i32){(int)w[0], (int)w[1], (int)w[2], (int)w[3], (int)w[4], (int)w[5], (int)w[6], (int)w[7]}; } }
  char* QL = lds + 2 * SHM_V + 2 * SHM_K + NW * 64 * 4 + wid * 4096 + lane * 32;
  *reinterpret_cast<v8i32*>(QL) = q8[0]; *reinterpret_cast<v8i32*>(QL + 2048) = q8[1];
  asm volatile("s_waitcnt lgkmcnt(0)" ::: "memory");
  const int sr = tid >> 4, sc = (tid & 15) * 8;
  const float dqb = dq0 + (float)(wid * QBLK + r32 - 4 * hi);
  struct { bf16x8 ks0, ks1; u32x4 v, v2; } sr_[SD];
#define SLOAD(i, t_) do { const unsigned io_ = (unsigned)((t0 + (t_)) * 8192 + tid * 16); sr_[i].v = *reinterpret_cast<const u32x4*>(V8a + io_); sr_[i].v2 = *reinterpret_cast<const u32x4*>(V8b + io_); \
    if constexpr (KIMG) sr_[i].ks0 = *reinterpret_cast<const bf16x8*>((const unsigned char*)Kh + io_); \
    else { sr_[i].ks0 = *reinterpret_cast<const bf16x8*>(&Kh[(unsigned)(((t_) * KVBLK + sr) * ldk + sc)]); sr_[i].ks1 = *reinterpret_cast<const bf16x8*>(&Kh[(unsigned)(((t_) * KVBLK + 32 + sr) * ldk + sc)]); } } while (0)
#define SWRITE(b, i) do { *(u32x4*)(V_lds + (b) * SHM_V + tid * 16) = sr_[i].v; *(u32x4*)(V_lds + (b) * SHM_V + 8192 + tid * 16) = sr_[i].v2; \
    if constexpr (KIMG) *(bf16x8*)(K_lds + (b) * SHM_K + tid * 16) = sr_[i].ks0; \
    else { typedef unsigned u32x2_ __attribute__((ext_vector_type(2))); unsigned l0_, h0_, l1_, h1_; bf8_to_f8(sr_[i].ks0, l0_, h0_); bf8_to_f8(sr_[i].ks1, l1_, h1_); \
    *(u32x2_*)(K_lds + (b) * SHM_K + K8OFF(sr, sc >> 4) + ((sc >> 3) & 1) * 8) = (u32x2_){l0_, h0_}; *(u32x2_*)(K_lds + (b) * SHM_K + K8OFF(32 + sr, sc >> 4) + ((sc >> 3) & 1) * 8) = (u32x2_){l1_, h1_}; } } while (0)
#define SWAIT() do { if constexpr (SD == 2) asm volatile("s_waitcnt vmcnt(%0)" :: "n"(KIMG ? 3 : 4) : "memory"); else asm volatile("s_waitcnt vmcnt(0)" ::: "memory"); } while (0)
#define RESC(a) do { if (__any((a) < 1.f)) { if (hi == 0) al_l[r32] = (a); asm volatile("s_waitcnt lgkmcnt(0)" ::: "memory"); \
    _Pragma("unroll") for (int d = 0; d < 8; ++d) _Pragma("unroll") for (int r = 0; r < 16; ++r) o[d][r] *= al_l[crow(r, hi)]; } } while (0)
#define QKT8L(P0_, P1_, KS_, q8_, r32_, hi_, DQ_, SL_) do { v8i32 qq_[2]; qq_[0] = *reinterpret_cast<const v8i32*>(QL); qq_[1] = *reinterpret_cast<const v8i32*>(QL + 2048); qkt8<MODE>(P0_, P1_, KS_, qq_, r32_, hi_, DQ_, SL_); } while (0)
  f32x16 pA0, pA1, pB0, pB1; float mnA, mnB, alA, alB; v8i32 pa;
  constexpr int SE = 0, SO = SD - 1; constexpr float TR = THR8 / SCALE;
  SLOAD(SE, 0); asm volatile("s_waitcnt vmcnt(0)" ::: "memory"); SWRITE(0, SE); __syncthreads();
  QKT8L(pA0, pA1, K_lds, q8, r32, hi, dqb, slopeS); partialSM(pA0, pA1, m_reg, mnA, alA, TR, PSC_LOG2);
  SLOAD(SO, 1); if constexpr (SD == 2) { if (2 < NT) SLOAD(SE, 2); }
  SWAIT(); SWRITE(1, SO); __syncthreads();
  for (int j = 1; j + 1 < NT; j += 2) {
    SBAR(); QKT8L(pB0, pB1, K_lds + SHM_K, q8, r32, hi, dqb - (float)(j * KVBLK), slopeS);
    finishSM8(pA0, pA1, alA, l_reg, pa); SBAR();
    SLOAD(SO, j + SD); SBAR();
    pv8(o, V_lds, pa, r32, hi); pv8(o + 4, V_lds + 8192, pa, r32, hi); partialSM(pB0, pB1, m_reg, mnB, alB, TR, PSC_LOG2);
    __syncthreads(); SWAIT(); SWRITE(0, SE);
    RESC(alB); __syncthreads();
    SBAR(); QKT8L(pA0, pA1, K_lds, q8, r32, hi, dqb - (float)((j + 1) * KVBLK), slopeS);
    finishSM8(pB0, pB1, alB, l_reg, pa); SBAR();
    if (SD == 1 || j + 3 < NT) SLOAD(SE, j + 1 + SD); SBAR();
    pv8(o, V_lds + SHM_V, pa, r32, hi); pv8(o + 4, V_lds + SHM_V + 8192, pa, r32, hi); partialSM(pA0, pA1, m_reg, mnA, alA, TR, PSC_LOG2);
    __syncthreads(); SWAIT(); SWRITE(1, SO);
    RESC(alA); __syncthreads();
  }
  SBAR(); QKT8L(pB0, pB1, K_lds + SHM_K, q8, r32, hi, dqb - (float)((NT - 1) * KVBLK), slopeS);
  finishSM8(pA0, pA1, alA, l_reg, pa); SBAR();
  pv8(o, V_lds, pa, r32, hi); pv8(o + 4, V_lds + 8192, pa, r32, hi); partialSM(pB0, pB1, m_reg, mnB, alB, TR, PSC_LOG2);
  __syncthreads(); RESC(alB);
  finishSM8(pB0, pB1, alB, l_reg, pa); SBAR();
  pv8(o, V_lds + SHM_V, pa, r32, hi); pv8(o + 4, V_lds + SHM_V + 8192, pa, r32, hi);
  if (hi == 0) li_l[r32] = l_reg; asm volatile("s_waitcnt lgkmcnt(0)" ::: "memory");
  float rli[16];
#pragma unroll
  for (int r = 0; r < 16; ++r) rli[r] = __builtin_amdgcn_rcpf(li_l[crow(r, hi)]);
  int ldo = ldo_; asm volatile("" : "+s"(ldo));
  bf16* Ow = Ob + (unsigned)((wid * QBLK) * ldo);
#pragma unroll
  for (int r = 0; r < 16; ++r) { const int orow = crow(r, hi);
#pragma unroll
    for (int d0 = 0; d0 < 8; ++d0) { const float v = o[d0][r] * rli[r]; unsigned u = __builtin_bit_cast(unsigned, v); u = (u + 0x7fffu + ((u >> 16) & 1u)) >> 16; Ow[(unsigned)(orow * ldo + d0 * 32 + r32)] = (bf16)u; } }
#undef QKT8L
#undef SLOAD
#undef SWRITE
#undef SWAIT
#undef RESC
}
__device__ __forceinline__ void v8t_tile(const bf16* __restrict__ Vrows, int ldv, unsigned char* __restrict__ img, __attribute__((address_space(3))) unsigned char* tl, int lane) {
  const int c0 = 8 * (lane & 15);
#pragma unroll 4
  for (int i = 0; i < 16; ++i) { const int key = 4 * i + (lane >> 4), pos = ((key >> 2) & 1) * 32 + (key >> 3) * 4 + (key & 3);
    unsigned lo, hh; bf8_to_f8(*reinterpret_cast<const bf16x8*>(Vrows + (unsigned)(key * ldv + c0)), lo, hh);
#pragma unroll
    for (int e = 0; e < 8; ++e) { const int c = c0 + e; tl[c * 64 + ((((pos >> 4) ^ ((c >> 2) & 3)) << 4) | (pos & 15))] = (unsigned char)(((e < 4 ? lo : hh) >> (8 * (e & 3))) & 0xffu); } }
  asm volatile("s_waitcnt lgkmcnt(0)" ::: "memory");
#pragma unroll
  for (int j = 0; j < 8; ++j) { const int ch = lane + 64 * j; *reinterpret_cast<u32x4*>(img + ch * 16) = *reinterpret_cast<const __attribute__((address_space(3))) u32x4*>(tl + ch * 16); }
  asm volatile("s_waitcnt lgkmcnt(0)" ::: "memory");
}
#undef KSWZ
#undef K8OFF
#undef SBAR
}

#define GAS __attribute__((address_space(1)))
#define LAS __attribute__((address_space(3)))
typedef unsigned short bf16;
typedef unsigned v4u __attribute__((ext_vector_type(4)));
typedef float f32x4 __attribute__((ext_vector_type(4)));
typedef short bf16x8 __attribute__((ext_vector_type(8)));
typedef GAS unsigned gu32;
typedef GAS unsigned long long gu64;
#define RLX_AGENT __ATOMIC_RELAXED, __HIP_MEMORY_SCOPE_AGENT
#define LDS_WAIT() asm volatile("s_waitcnt lgkmcnt(0)" ::: "memory")
#define VM_WAIT() asm volatile("s_waitcnt vmcnt(0)" ::: "memory")
__device__ __forceinline__ unsigned long long rt() { return __builtin_amdgcn_s_memrealtime(); }
__device__ __forceinline__ unsigned f2bf(float f) { unsigned u = __builtin_bit_cast(unsigned, f); return (u + 0x7fffu + ((u >> 16) & 1u)) >> 16; }
__device__ __forceinline__ unsigned pk2(float lo, float hi) { return f2bf(lo) | (f2bf(hi) << 16); }

#define XB_TMO      128
#define XB_XCNT(j)  (256  + 64 * (j))
#define XB_XSUB(j)  (1280 + 64 * (j))
#define XB_XGEN(j)  (2304 + 64 * (j))
#define XB_TOP      3328
#define XB_TOPGEN   3392
#define XCD_BAR_WORDS 3456
#define XB_SPIN_CAP (1u << 18)

__device__ __forceinline__ unsigned xb_ld(unsigned* p)              { return __hip_atomic_load(p, __ATOMIC_RELAXED, __HIP_MEMORY_SCOPE_AGENT); }
__device__ __forceinline__ unsigned xb_add(unsigned* p, unsigned v) { return __hip_atomic_fetch_add(p, v, __ATOMIC_RELAXED, __HIP_MEMORY_SCOPE_AGENT); }
__device__ __forceinline__ unsigned xb_xcc_id() { return (unsigned)__builtin_amdgcn_s_getreg((3 << 11) | 20) & 0xFu; }
#define XB_SPIN(cond, bar) do { unsigned _sp = 0; while (cond) { __builtin_amdgcn_s_sleep(1); \
    if ((++_sp & 255u) == 0u) { if (xb_ld(&(bar)[XB_TMO])) break; if (_sp > XB_SPIN_CAP) { atomicAdd(&(bar)[XB_TMO], 1u); break; } } } } while (0)

struct XcdBarrier {
    unsigned* bar; unsigned x;
    volatile LAS unsigned* st;
};

__device__ __forceinline__ XcdBarrier xcd_barrier_post(unsigned* bar, volatile LAS unsigned* st) {
    XcdBarrier b; b.bar = bar; b.x = xb_xcc_id(); b.st = st;
    if (threadIdx.x == 0) (void)xb_add(&bar[XB_XCNT(b.x)], 1u);
    return b;
}
__device__ __forceinline__ void xcd_barrier_complete(unsigned* bar, unsigned x, unsigned& nloc, unsigned& nx) {
    const unsigned G = gridDim.x * gridDim.y * gridDim.z;
    unsigned sum, cnt, mine, sp = 0u;
    for (;;) {
        sum = 0u; cnt = 0u; mine = 0u;
#pragma unroll
        for (unsigned j = 0; j < 16; ++j) { const unsigned c = xb_ld(&bar[XB_XCNT(j)]); sum += c; cnt += (c > 0u) ? 1u : 0u; mine = (j == x) ? c : mine; }
        if (sum == G) break;
        __builtin_amdgcn_s_sleep(1);
        if ((++sp & 255u) == 0u) { if (xb_ld(&bar[XB_TMO])) break; if (sp > XB_SPIN_CAP) { atomicAdd(&bar[XB_TMO], 1u); break; } }
    }
    nloc = mine > 0u ? mine : 1u; nx = cnt > 0u ? cnt : 1u;
}

__device__ __forceinline__ void xcd_barrier(const XcdBarrier& b) {
    asm volatile("s_waitcnt vmcnt(0)" ::: "memory");
    __syncthreads();
    if (threadIdx.x == 0) {
        unsigned* bar = b.bar;
        __builtin_amdgcn_s_waitcnt(0);
        unsigned nloc = b.st[0], nx = b.st[1];
        if (nloc == 0u) { xcd_barrier_complete(bar, b.x, nloc, nx); b.st[0] = nloc; b.st[1] = nx; }
        const unsigned old = xb_add(&bar[XB_XSUB(b.x)], 1u);
        const unsigned gen = old / nloc;
        if (old + 1u == (gen + 1u) * nloc) {
            __builtin_amdgcn_fence(__ATOMIC_RELEASE, "agent");
            asm volatile("s_waitcnt vmcnt(0)" ::: "memory");
            const unsigned og = xb_add(&bar[XB_TOP], 1u);
            const unsigned tg = og / nx;
            if (og + 1u == (tg + 1u) * nx) xb_add(&bar[XB_TOPGEN], 1u);
            else XB_SPIN(xb_ld(&bar[XB_TOPGEN]) == tg, bar);
            __builtin_amdgcn_fence(__ATOMIC_ACQUIRE, "agent");
            xb_add(&bar[XB_XGEN(b.x)], 1u);
            asm volatile("s_waitcnt vmcnt(0)" ::: "memory");
        } else {
            XB_SPIN(xb_ld(&bar[XB_XGEN(b.x)]) == gen, bar);
            __builtin_amdgcn_fence(__ATOMIC_ACQUIRE, "agent");
            asm volatile("s_waitcnt vmcnt(0)" ::: "memory");
        }
    }
    __syncthreads();
}
#ifndef ATT_SD0
#define ATT_SD0 2
#endif
#ifndef ATT_QK8_GQA
#define ATT_QK8_GQA 1
#endif
#ifndef ATT_GQA_F8
#define ATT_GQA_F8 1
#endif
#ifndef GQA_KIMG
#define GQA_KIMG 1
#endif
#ifndef DIFF_KIMG
#define DIFF_KIMG 1
#endif
#ifndef DIFF_F8_DV2
#define DIFF_F8_DV2 1
#endif
#ifndef DIFF_LSE_WIN
#define DIFF_LSE_WIN 1
#endif
constexpr int LSE_H0 = 3, LSE_NC = 2 * (8 - LSE_H0);
#ifndef DIFF_F8_HMIN
#define DIFF_F8_HMIN 5
#endif
#ifndef ATT_QK8_DIFF
#define ATT_QK8_DIFF 0
#endif
#ifndef ATT_QK8_DIL
#define ATT_QK8_DIL 0
#endif
#ifndef ATT_SD1F
#define ATT_SD1F 1
#endif
#ifndef ATT_SD1
#define ATT_SD1 2
#endif
#ifndef ATT_SD2
#define ATT_SD2 2
#endif
constexpr int NWAVES = 8;
constexpr int BATCH = 2, SEQ = 16384, DM = 2048, T = BATCH * SEQ, HD = 128;
constexpr int L0_IN = 4608, L1_IN = 6144, FF0 = 5632, FFE = 7168, NE = 8;
constexpr float NORM_EPS = 1e-6f;
constexpr float LAMBDA_INIT = 0.35550906759096927f;
constexpr int P_MAX_TILES = 264;
constexpr float SC_WGU = 64.f, SC_WD = 128.f, SC_ACT = 4.f;
#ifndef INPROJ0_F8
#define INPROJ0_F8 2
#endif
#ifndef FFN0_F8
#define FFN0_F8 0
#endif
#ifndef MK_N_LAUNCHES
#define MK_N_LAUNCHES 1
#endif
constexpr int N_PHASES = 20;
constexpr int N_LAUNCHES = MK_N_LAUNCHES;
static_assert(N_LAUNCHES == 1 || N_LAUNCHES == N_PHASES, "MK_N_LAUNCHES is 1 or N_PHASES");

constexpr size_t MiB = 1u << 20;
constexpr size_t WS_CTL = 0, CTL_ZERO_BYTES = 1 * MiB;
constexpr size_t WS_ROPE = 1 * MiB;
constexpr size_t WS_CNT = 1 * MiB + 128 * 1024;
constexpr size_t WS_TOT = 1 * MiB + 192 * 1024;
constexpr size_t WS_TOKE = 2 * MiB;
constexpr size_t WS_TOKG = 3 * MiB;
constexpr size_t WS_TOKS = 4 * MiB;
constexpr size_t WS_LSE = 5 * MiB;
constexpr size_t WS_W8A = 8 * MiB;
constexpr size_t WS_WIN0 = 16 * MiB, WS_WOUT0 = 34 * MiB, WS_WGU0 = 42 * MiB, WS_WD0 = 86 * MiB, WS_WIN1 = 108 * MiB, WS_WOUT1 = 132 * MiB;
constexpr size_t WS_WGUE = 140 * MiB, WS_WDE = 364 * MiB;
constexpr size_t WS_ARENA = 476 * MiB, WS_END = 1840 * MiB;
constexpr size_t A_H = 0, A_PROJ0 = 128 * MiB, A_OB = 416 * MiB, A_MIX = 608 * MiB;
constexpr size_t A_H8A = 736 * MiB;
constexpr size_t A_K8T = 1000 * MiB;
constexpr size_t A_V8T = 992 * MiB;
constexpr size_t A_ACT0 = 128 * MiB;
constexpr size_t A_K8D = 864 * MiB;
constexpr size_t A_V8D = 800 * MiB;
constexpr size_t A_PROJ1 = 128 * MiB, A_OC = 512 * MiB;
constexpr size_t A_XS = 0, A_HFB = 132 * MiB, A_ACT = 196 * MiB, A_Y = 658 * MiB;
static_assert(A_Y + (size_t)P_MAX_TILES * 256 * DM * 2 <= WS_END - WS_ARENA && A_ACT + (size_t)P_MAX_TILES * 256 * FFE <= A_Y && A_XS + (size_t)P_MAX_TILES * 256 * DM <= A_HFB && A_HFB + (size_t)T * DM <= A_ACT, "arena map (MoE)");
static_assert(A_MIX + (size_t)T * DM * 2 <= WS_END - WS_ARENA && A_OC + 2 * (size_t)T * DM * 2 <= WS_END - WS_ARENA && A_ACT0 + (size_t)T * FF0 * 2 <= WS_END - WS_ARENA, "arena map");
static_assert(WS_WDE + (size_t)NE * DM * FFE <= WS_ARENA && WS_WGUE + (size_t)NE * 2 * FFE * DM <= WS_WDE && WS_WOUT1 + (size_t)DM * DM * 2 <= WS_WGUE, "weight map");
constexpr int CW_TMO = 0, CW_CODE = 1;
constexpr int CW_BAR = 4096;
constexpr int CW_Q0 = 8192, CW_Q1 = 8192 + 64, CW_Q2 = 8192 + 128, CW_Q3 = 8192 + 192;
constexpr int CW_PROBE = 8192 + 1024;
constexpr int CW_WIN = 16384;

constexpr int RING_OFF = 0, RING_BYTES = 131072;
constexpr int LDSCTL_OFF = RING_BYTES, MISC_OFF = LDSCTL_OFF + 320;
constexpr int LDS_BYTES = 147456;
static_assert(MISC_OFF + 128 <= LDS_BYTES, "LDS map");

struct Frame {
    LAS unsigned char* lds;
    volatile LAS unsigned* MISC;
    gu32* ctl;
    int vcu, G;
};
typedef float f32x2 __attribute__((ext_vector_type(2)));
typedef int i32x2 __attribute__((ext_vector_type(2)));

__device__ __forceinline__ float wave_sum(float v) {
#pragma unroll
    for (int o = 1; o < 64; o <<= 1) v += __shfl_xor(v, o);
    return v;
}
__device__ __forceinline__ float bflo(unsigned w) { return __uint_as_float(w << 16); }
__device__ __forceinline__ float bfhi(unsigned w) { return __uint_as_float(w & 0xffff0000u); }
__device__ __forceinline__ void unpack8(const v4u w, float (&v)[8]) { v[0] = bflo(w.x); v[1] = bfhi(w.x); v[2] = bflo(w.y); v[3] = bfhi(w.y); v[4] = bflo(w.z); v[5] = bfhi(w.z); v[6] = bflo(w.w); v[7] = bfhi(w.w); }
__device__ __forceinline__ v4u pack8(const float (&v)[8]) { v4u w; w.x = pk2(v[0], v[1]); w.y = pk2(v[2], v[3]); w.z = pk2(v[4], v[5]); w.w = pk2(v[6], v[7]); return w; }

__device__ __forceinline__ void transpose_item(const float* __restrict__ W, int N, bf16* __restrict__ WT, size_t ldt, int k0, int n0, int drow0, LAS float* scr, int lane) {
#pragma unroll 8
    for (int i = 0; i < 32; ++i) { const int kk = 2 * i + (lane >> 5); scr[kk * 33 + (lane & 31)] = W[(size_t)(k0 + kk) * N + n0 + (lane & 31)]; }
    LDS_WAIT(); asm volatile("" ::: "memory");
    const int c = lane & 7;
#pragma unroll
    for (int j = 0; j < 4; ++j) { const int n = (lane >> 3) + 8 * j; const LAS float* s = scr + (8 * c) * 33 + n;
        v4u o; o.x = pk2(s[0 * 33], s[1 * 33]); o.y = pk2(s[2 * 33], s[3 * 33]); o.z = pk2(s[4 * 33], s[5 * 33]); o.w = pk2(s[6 * 33], s[7 * 33]);
        *(v4u*)(WT + (size_t)(drow0 + n) * ldt + k0 + 8 * c) = o; }
    LDS_WAIT(); asm volatile("" ::: "memory");
}
__device__ __forceinline__ void tr_plain(const float* W, int K, int N, bf16* WT, int r, LAS float* scr, int lane) {
    const int nblk = N / 32, kb = r / nblk, nb = r % nblk; transpose_item(W, N, WT, (size_t)K, 64 * kb, 32 * nb, 32 * nb, scr, lane);
}
__device__ __forceinline__ void tr_gu(const float* W, int K, int N, bf16* WT, int half, int r, LAS float* scr, int lane) {
    const int nblk = N / 32, kb = r / nblk, nb = r % nblk, n0 = 32 * nb; transpose_item(W, N, WT, (size_t)K, 64 * kb, n0, (n0 >> 7) * 256 + half * 128 + (n0 & 127), scr, lane);
}
__device__ __forceinline__ unsigned pk4_fp8(float a, float b, float c, float d) { unsigned w = 0u; w = __builtin_amdgcn_cvt_pk_fp8_f32(a, b, w, false); w = __builtin_amdgcn_cvt_pk_fp8_f32(c, d, w, true); return w; }
__device__ __forceinline__ void transpose_item_f8(const float* __restrict__ W, int N, unsigned char* __restrict__ WT, size_t ldt, int k0, int n0, int drow0, float sc, LAS float* scr, int lane) {
#pragma unroll 8
    for (int i = 0; i < 32; ++i) { const int kk = 2 * i + (lane >> 5); scr[kk * 33 + (lane & 31)] = W[(size_t)(k0 + kk) * N + n0 + (lane & 31)]; }
    LDS_WAIT(); asm volatile("" ::: "memory");
    const int c = lane & 3;
#pragma unroll
    for (int j = 0; j < 2; ++j) { const int n = (lane >> 2) + 16 * j; const LAS float* s = scr + (16 * c) * 33 + n;
        v4u o; o.x = pk4_fp8(s[0 * 33] * sc, s[1 * 33] * sc, s[2 * 33] * sc, s[3 * 33] * sc); o.y = pk4_fp8(s[4 * 33] * sc, s[5 * 33] * sc, s[6 * 33] * sc, s[7 * 33] * sc);
        o.z = pk4_fp8(s[8 * 33] * sc, s[9 * 33] * sc, s[10 * 33] * sc, s[11 * 33] * sc); o.w = pk4_fp8(s[12 * 33] * sc, s[13 * 33] * sc, s[14 * 33] * sc, s[15 * 33] * sc);
        *(v4u*)(WT + (size_t)(drow0 + n) * ldt + k0 + 16 * c) = o; }
    LDS_WAIT(); asm volatile("" ::: "memory");
}
__device__ __forceinline__ void tr_plain_f8(const float* W, int K, int N, unsigned char* WT, float sc, int r, LAS float* scr, int lane) {
    const int nblk = N / 32, kb = r / nblk, nb = r % nblk; transpose_item_f8(W, N, WT, (size_t)K, 64 * kb, 32 * nb, 32 * nb, sc, scr, lane);
}
__device__ __forceinline__ void tr_gu_f8(const float* W, int K, int N, unsigned char* WT, int half, float sc, int r, LAS float* scr, int lane) {
    const int nblk = N / 32, kb = r / nblk, nb = r % nblk, n0 = 32 * nb; transpose_item_f8(W, N, WT, (size_t)K, 64 * kb, n0, (n0 >> 7) * 256 + half * 128 + (n0 & 127), sc, scr, lane);
}
__device__ __forceinline__ void rms_row_to_bf16(const float* __restrict__ xrow, const float* __restrict__ g, bf16* __restrict__ orow, int lane) {
    const f32x4* xr = (const f32x4*)xrow + lane;
    f32x4 v[8]; float s = 0.f;
#pragma unroll
    for (int j = 0; j < 8; ++j) { v[j] = xr[64 * j]; s += (v[j].x * v[j].x + v[j].y * v[j].y) + (v[j].z * v[j].z + v[j].w * v[j].w); }
    const float rstd = rsqrtf(wave_sum(s) * (1.f / DM) + NORM_EPS);
    const f32x4* gr = (const f32x4*)g + lane;
    unsigned long long* o8 = (unsigned long long*)orow + lane;
#pragma unroll
    for (int j = 0; j < 8; ++j) { const f32x4 gg = gr[64 * j];
        o8[64 * j] = (unsigned long long)pk2(v[j].x * rstd * gg.x, v[j].y * rstd * gg.y) | ((unsigned long long)pk2(v[j].z * rstd * gg.z, v[j].w * rstd * gg.w) << 32); }
}
__device__ __forceinline__ void rms_row_to_fp8(const float* __restrict__ xrow, const float* __restrict__ g, unsigned char* __restrict__ orow, int lane) {
    const f32x4* xr = (const f32x4*)xrow + lane;
    f32x4 v[8]; float s = 0.f;
#pragma unroll
    for (int j = 0; j < 8; ++j) { v[j] = xr[64 * j]; s += (v[j].x * v[j].x + v[j].y * v[j].y) + (v[j].z * v[j].z + v[j].w * v[j].w); }
    const float rstd = rsqrtf(wave_sum(s) * (1.f / DM) + NORM_EPS);
    const f32x4* gr = (const f32x4*)g + lane;
    unsigned* o4 = (unsigned*)orow + lane;
#pragma unroll
    for (int j = 0; j < 8; ++j) { const f32x4 gg = gr[64 * j]; o4[64 * j] = pk4_fp8(v[j].x * rstd * gg.x, v[j].y * rstd * gg.y, v[j].z * rstd * gg.z, v[j].w * rstd * gg.w); }
}
__device__ __forceinline__ void rms_row_to_both(const float* __restrict__ xrow, const float* __restrict__ g, bf16* __restrict__ orow, unsigned char* __restrict__ orow8, int lane) {
    const f32x4* xr = (const f32x4*)xrow + lane;
    f32x4 v[8]; float s = 0.f;
#pragma unroll
    for (int j = 0; j < 8; ++j) { v[j] = xr[64 * j]; s += (v[j].x * v[j].x + v[j].y * v[j].y) + (v[j].z * v[j].z + v[j].w * v[j].w); }
    const float rstd = rsqrtf(wave_sum(s) * (1.f / DM) + NORM_EPS);
    const f32x4* gr = (const f32x4*)g + lane;
    unsigned long long* o8 = (unsigned long long*)orow + lane; unsigned* o4 = (unsigned*)orow8 + lane;
#pragma unroll
    for (int j = 0; j < 8; ++j) { const f32x4 gg = gr[64 * j]; const float a = v[j].x * rstd * gg.x, b = v[j].y * rstd * gg.y, c = v[j].z * rstd * gg.z, d = v[j].w * rstd * gg.w;
        o8[64 * j] = (unsigned long long)pk2(a, b) | ((unsigned long long)pk2(c, d) << 32); o4[64 * j] = pk4_fp8(a, b, c, d); }
}
__device__ __forceinline__ void norm_rows_phase(int gw, int NGW, int lane, const float* x, const float* g, bf16* Hd) {
    for (int m = gw; m < T; m += NGW) rms_row_to_bf16(x + (size_t)m * DM, g, Hd + (size_t)m * DM, lane);
}

struct Args { const float* in[27]; float* out; unsigned char* ws; int ph_lo, ph_hi; };
static_assert(sizeof(Args) == 27 * 8 + 8 + 8 + 8, "Args has no padding");

#define AS4 __attribute__((address_space(4)))
#define PH_BEGIN int tid = threadIdx.x; asm volatile("" : "+v"(tid)); const int lane = tid & 63, wave = __builtin_amdgcn_readfirstlane(tid >> 6), gw = F.vcu * NWAVES + wave, NGW = F.G * NWAVES; (void)lane; (void)gw; (void)NGW; \
    const AS4 unsigned char* kp = (const AS4 unsigned char*)__builtin_amdgcn_kernarg_segment_ptr(); asm volatile("" : "+s"(kp)); \
    unsigned char* const wsb = *(unsigned char* const AS4*)(kp + 224); unsigned char* const arena = wsb + WS_ARENA; float* const outp = *(float* const AS4*)(kp + 216); (void)arena; (void)outp
#define INP(k) (*(const float* const AS4*)(kp + 8 * (k)))
#define W_IN0 ((bf16*)(wsb + WS_WIN0))
#define W_OUT0 ((bf16*)(wsb + WS_WOUT0))
#define W_GU0 ((bf16*)(wsb + WS_WGU0))
#define W_D0 ((bf16*)(wsb + WS_WD0))
#define W_IN1 ((bf16*)(wsb + WS_WIN1))
#define W_OUT1 ((bf16*)(wsb + WS_WOUT1))
#define W_GUE ((unsigned char*)(wsb + WS_WGUE))
#define W_DE ((unsigned char*)(wsb + WS_WDE))
#define H ((bf16*)(arena + A_H))
#define PROJ0 ((bf16*)(arena + A_PROJ0))
#define OB ((bf16*)(arena + A_OB))
#define MIX ((bf16*)(arena + A_MIX))
#define H8A ((unsigned char*)(arena + A_H8A))
#define W8A ((unsigned char*)(wsb + WS_W8A))
#define V8T ((unsigned char*)(arena + A_V8T))
#define K8T ((unsigned char*)(arena + A_K8T))
#define V8D ((unsigned char*)(arena + A_V8D))
#define K8D ((unsigned char*)(arena + A_K8D))
#define ACT0 ((bf16*)(arena + A_ACT0))
#define PROJ1 ((bf16*)(arena + A_PROJ1))
#define OC ((bf16*)(arena + A_OC))
#define XS ((unsigned char*)(arena + A_XS))
#define ACT ((unsigned char*)(arena + A_ACT))
#define HFB ((unsigned char*)(arena + A_HFB))
#define Y ((bf16*)(arena + A_Y))
#define ROPE ((f32x2*)(wsb + WS_ROPE))
#define LSE ((float*)(wsb + WS_LSE))
#define CNT ((int*)(wsb + WS_CNT))
#define TOT ((int*)(wsb + WS_TOT))
#define TOKE ((i32x2*)(wsb + WS_TOKE))
#define TOKG ((f32x2*)(wsb + WS_TOKG))
#define TOKS ((i32x2*)(wsb + WS_TOKS))
#ifndef CONV_IN_P3
#define CONV_IN_P3 1
#endif
constexpr int MIXA_COLS = 1536;
constexpr int I0 = (DM / 64) * (L0_IN / 32), I1 = (DM / 64) * (DM / 32), I2 = (DM / 64) * (FF0 / 32), I4 = (FF0 / 64) * (DM / 32), I5 = (DM / 64) * (L1_IN / 32);
constexpr int IE = (DM / 64) * (FFE / 32), IED = (FFE / 64) * (DM / 32);
constexpr int NEARLY = I0, NITEMS = I0 + I1 + 2 * I2 + I4 + I5 + I1 + NE * (2 * IE + IED);
constexpr int CONV_BATCH = 512, N_CONV_BATCH = (NITEMS - NEARLY) / CONV_BATCH;
static_assert((NITEMS - NEARLY) % CONV_BATCH == 0 && 3 * N_CONV_BATCH >= 1024, "late conversion items: whole batches, one batch per three GQA units");
#define CONVERT_ITEM(it_) do { int r = (it_); \
            if (r < I0) { if (INPROJ0_F8 == 1) tr_plain_f8(INP(2), DM, L0_IN, (unsigned char*)W_IN0, SC_WGU, r, scr, lane); else if (INPROJ0_F8 == 2 && 32 * (r % (L0_IN / 32)) < MIXA_COLS) tr_plain_f8(INP(2), DM, L0_IN, W8A, SC_WGU, r, scr, lane); else tr_plain(INP(2), DM, L0_IN, W_IN0, r, scr, lane); break; } r -= I0; \
            if (r < I1) { tr_plain(INP(7), DM, DM, W_OUT0, r, scr, lane); break; } r -= I1; \
            if (r < I2) { if (FFN0_F8) tr_gu_f8(INP(9), DM, FF0, (unsigned char*)W_GU0, 0, SC_WGU, r, scr, lane); else tr_gu(INP(9), DM, FF0, W_GU0, 0, r, scr, lane); break; } r -= I2; \
            if (r < I2) { if (FFN0_F8) tr_gu_f8(INP(10), DM, FF0, (unsigned char*)W_GU0, 1, SC_WGU, r, scr, lane); else tr_gu(INP(10), DM, FF0, W_GU0, 1, r, scr, lane); break; } r -= I2; \
            if (r < I4) { tr_plain(INP(11), FF0, DM, W_D0, r, scr, lane); break; } r -= I4; \
            if (r < I5) { tr_plain(INP(13), DM, L1_IN, W_IN1, r, scr, lane); break; } r -= I5; \
            if (r < I1) { tr_plain(INP(21), DM, DM, W_OUT1, r, scr, lane); break; } r -= I1; \
            if (r < NE * IE) { const int e = r / IE; tr_gu_f8(INP(24) + (size_t)e * DM * FFE, DM, FFE, W_GUE + (size_t)e * 2 * FFE * DM, 0, SC_WGU, r % IE, scr, lane); break; } r -= NE * IE; \
            if (r < NE * IE) { const int e = r / IE; tr_gu_f8(INP(25) + (size_t)e * DM * FFE, DM, FFE, W_GUE + (size_t)e * 2 * FFE * DM, 1, SC_WGU, r % IE, scr, lane); break; } r -= NE * IE; \
            { const int e = r / IED; tr_plain_f8(INP(26) + (size_t)e * FFE * DM, FFE, DM, W_DE + (size_t)e * DM * FFE, SC_WD, r % IED, scr, lane); } \
        } while (0)
__global__ void __launch_bounds__(NWAVES * 64, 2) mk_fwd(Args args) {
    extern __shared__ __attribute__((aligned(16))) unsigned char lds[];
    Frame F;
    F.lds = (LAS unsigned char*)lds;
    F.MISC = (volatile LAS unsigned*)(F.lds + MISC_OFF);
    F.G = gridDim.x; { const int bx = blockIdx.x; F.vcu = (F.G % 8 == 0) ? (bx % 8) * (F.G / 8) + bx / 8 : bx; }
    { const AS4 unsigned char* kp0 = (const AS4 unsigned char*)__builtin_amdgcn_kernarg_segment_ptr(); F.ctl = (gu32*)(*(unsigned char* const AS4*)(kp0 + 224) + WS_CTL); }
    for (int u = threadIdx.x; u < (LDS_BYTES - LDSCTL_OFF) / 4; u += NWAVES * 64) ((LAS unsigned*)(F.lds + LDSCTL_OFF))[u] = 0u;
    __syncthreads();
    XcdBarrier bar; bar.bar = (unsigned*)(F.ctl + CW_BAR); bar.x = 0; bar.st = nullptr;
    if (N_LAUNCHES == 1) bar = xcd_barrier_post((unsigned*)(F.ctl + CW_BAR), F.MISC + 8);
#define GRID_BAR() do { if (N_LAUNCHES == 1) { xcd_barrier(bar); } } while (0)
    int lo, hi; { const AS4 unsigned char* kp0 = (const AS4 unsigned char*)__builtin_amdgcn_kernarg_segment_ptr(); lo = *(const AS4 int*)(kp0 + 232); hi = *(const AS4 int*)(kp0 + 236); }
#ifndef PROBE_DUP
#define PROBE_DUP 0u
#endif
#define REPS(k) (1 + (int)((PROBE_DUP >> (k)) & 1u))
#ifndef PROBE_BARS
#define PROBE_BARS 0
#endif
#ifndef PROBE_ATT
#define PROBE_ATT 0
#endif
#ifndef PH_MASK
#define PH_MASK 0xffffffffu
#endif
#define IN(k) (((PH_MASK >> (k)) & 1u) && lo <= (k) && (k) < hi)
#define SEAM(k) do { if (IN(k) && IN((k) + 1)) GRID_BAR(); } while (0)
    for (int rep_ = 0; rep_ < (IN(0) ? REPS(0) : 0); ++rep_) {
        PH_BEGIN;
        LAS float* scr = (LAS float*)(F.lds + RING_OFF + wave * 16384);
        for (int it = gw; it < (CONV_IN_P3 ? NEARLY : NITEMS); it += NGW) CONVERT_ITEM(it);
        for (int i = blockIdx.x * (NWAVES * 64) + tid; i < 256 * 32; i += F.G * NWAVES * 64) {
            const int idx = i >> 5, f = i & 31;
            const float inv = exp2f(-(float)f * (13.287712379549449f / 32.f));
            const float ang = (float)idx * inv;
            const float k = rintf(ang * 0.15915494309189535f);
            float rr = fmaf(-k, 6.28125f, ang); rr = fmaf(-k, 1.9353071795864769e-3f, rr);
            ROPE[i] = (f32x2){cosf(rr), sinf(rr)};
        }
        if (INPROJ0_F8 == 1) { for (int m = gw; m < T; m += NGW) rms_row_to_fp8(INP(0) + (size_t)m * DM, INP(1), (unsigned char*)H + (size_t)m * DM, lane); }
        else if (INPROJ0_F8 == 2) { for (int m = gw; m < T; m += NGW) rms_row_to_both(INP(0) + (size_t)m * DM, INP(1), H + (size_t)m * DM, H8A + (size_t)m * DM, lane); }
        else norm_rows_phase(gw, NGW, lane, INP(0), INP(1), H);
    }
    SEAM(0);
    for (int rep_ = 0; rep_ < (IN(1) ? REPS(1) : 0); ++rep_) {
        PH_BEGIN;
        if (INPROJ0_F8 == 2) {
            { pg8::Gemm g{(const bf16*)H8A, (const bf16*)W8A, T, MIXA_COLS, DM / 2}; pg8::StaticOrder S; S.init(T, MIXA_COLS, F.G, (int)blockIdx.x);
              pg8::EpiBf16 E{PROJ0, L0_IN, 1.f / SC_WGU};
              pg8::gemm_phase<pg8::EpiBf16, pg8::StaticOrder, true, true, true>(F.lds + RING_OFF, g, S, E); }
            __syncthreads();
            { pg8::Gemm g{H, W_IN0 + (size_t)MIXA_COLS * DM, T, L0_IN - MIXA_COLS, DM}; pg8::StaticOrder S; S.init(T, L0_IN - MIXA_COLS, F.G, (int)blockIdx.x);
              pg8::EpiBf16 E{PROJ0 + MIXA_COLS, L0_IN, 1.f};
              pg8::gemm_phase<pg8::EpiBf16, pg8::StaticOrder, true, true, false>(F.lds + RING_OFF, g, S, E); }
        } else {
        pg8::Gemm g{H, W_IN0, T, L0_IN, INPROJ0_F8 ? DM / 2 : DM}; pg8::StaticOrder S; S.init(T, L0_IN, F.G, (int)blockIdx.x);
        pg8::EpiBf16 E{PROJ0, L0_IN, INPROJ0_F8 ? 1.f / SC_WGU : 1.f};
        pg8::gemm_phase<pg8::EpiBf16, pg8::StaticOrder, true, true, (INPROJ0_F8 == 1)>(F.lds + RING_OFF, g, S, E);
        }
    }
    SEAM(1);
    for (int rep_ = 0; rep_ < (IN(2) ? REPS(2) : 0); ++rep_) {
        PH_BEGIN;
        const int sub = lane >> 4, j = lane & 15;
        LAS unsigned char* kimg = F.lds + RING_OFF;
        for (int c = blockIdx.x; c < 256; c += F.G) {
        __syncthreads();
        for (int i = wave; i < 128; i += NWAVES) {
            const int t = c * 128 + i;
            const int s = t % SEQ, prow = s >> 6, pcol = s & 63;
            bf16* row = PROJ0 + (size_t)t * L0_IN;
#pragma unroll
            for (int seg = 0; seg < 4; ++seg) {
                const int col0 = seg == 0 ? 0 : seg == 1 ? 1024 : seg == 2 ? 1536 : 2560;
                const int nh = seg == 1 ? 2 : 8;
                const float* g = INP(3 + seg);
                const bool rope = seg < 2;
                const f32x4 ga = *(const f32x4*)(g + j * 8), gb = *(const f32x4*)(g + j * 8 + 4);
                for (int it = 0; it * 4 < nh; ++it) {
                    const int head = it * 4 + sub; const bool act = head < nh;
                    bf16* p = row + col0 + (act ? head : 0) * HD + j * 8;
                    const v4u w = *(const v4u*)p;
                    float v[8]; unpack8(w, v);
                    float ss = 0.f;
#pragma unroll
                    for (int i = 0; i < 8; ++i) ss += v[i] * v[i];
                    ss += __shfl_xor(ss, 1); ss += __shfl_xor(ss, 2); ss += __shfl_xor(ss, 4); ss += __shfl_xor(ss, 8);
                    const float rstd = rsqrtf(ss * (1.f / HD) + NORM_EPS);
                    v[0] *= rstd * ga.x; v[1] *= rstd * ga.y; v[2] *= rstd * ga.z; v[3] *= rstd * ga.w; v[4] *= rstd * gb.x; v[5] *= rstd * gb.y; v[6] *= rstd * gb.z; v[7] *= rstd * gb.w;
                    if (rope) {
                        const int idx = (j < 8) ? prow : pcol; const f32x4* cs = (const f32x4*)(ROPE + idx * 32 + 8 * (j & 3));
                        const float sgn = (j & 4) ? 1.f : -1.f;
#pragma unroll
                        for (int q = 0; q < 4; ++q) { const f32x4 c2 = cs[q];
                            const float pa = __shfl_xor(v[2 * q], 4), pb = __shfl_xor(v[2 * q + 1], 4);
                            v[2 * q] = v[2 * q] * c2.x + sgn * pa * c2.y; v[2 * q + 1] = v[2 * q + 1] * c2.z + sgn * pb * c2.w; }
                    }
                    if (act) { const v4u pw = pack8(v); *(v4u*)p = pw;
                        if (GQA_KIMG && seg == 1) { unsigned lo8, hi8; att::bf8_to_f8(__builtin_bit_cast(att::bf16x8, pw), lo8, hi8); typedef unsigned u32x2_ __attribute__((ext_vector_type(2)));
                            *(LAS u32x2_*)(kimg + (((i >> 6) * 2 + head) * 8192 + att::k8off(i & 63, j >> 1) + (j & 1) * 8)) = (u32x2_){lo8, hi8}; } }
                }
            }
        }
        __syncthreads();
        if (GQA_KIMG) { const int bb = c >> 7, t0 = (c & 127) * 2;
            for (int q = tid; q < 4 * 512; q += NWAVES * 64) { const int img = q >> 9, tl = img >> 1, kvh = img & 1;
                *(v4u*)(K8T + ((size_t)((bb * 2 + kvh) * 256 + t0 + tl) * 8192 + (q & 511) * 16)) = *(const LAS v4u*)(kimg + (size_t)q * 16); } }
        }
        if (ATT_GQA_F8) {
            __syncthreads();
            for (int tile = gw; tile < 1024; tile += NGW) { const int b = tile >> 9, kvh = (tile >> 8) & 1, t = tile & 255;
                att::v8t_tile(PROJ0 + ((size_t)b * SEQ + t * 64) * L0_IN + 1280 + kvh * HD, L0_IN, V8T + (size_t)tile * 8192, F.lds + RING_OFF + wave * 16384, lane); }
        }
    }
    SEAM(2);
    for (int rep_ = 0; rep_ < (IN(3) ? REPS(3) : 0); ++rep_) {
        PH_BEGIN;
#ifndef P3_PART
#define P3_PART 3
#endif
        if (P3_PART & 1) {
        gu32* head = F.ctl + CW_Q0 + 256 * rep_;
        LAS float* scr = (LAS float*)(F.lds + RING_OFF + wave * 16384);
        for (;;) {
            __syncthreads();
            if (tid == 0) F.MISC[16] = __hip_atomic_fetch_add(head, 1u, RLX_AGENT);
            __syncthreads();
            int u = __builtin_amdgcn_readfirstlane((int)F.MISC[16]);
            if (CONV_IN_P3) { const int e = u;
                if (e >= 4 * N_CONV_BATCH) break;
                if ((e & 3) == 3) { const int it0 = NEARLY + (e >> 2) * CONV_BATCH + wave * (CONV_BATCH / NWAVES);
                    for (int k = 0; k < CONV_BATCH / NWAVES; ++k) CONVERT_ITEM(it0 + k);
                    continue; }
                u = 3 * (e >> 2) + (e & 3);
                if (u >= 1024) continue;
            } else if (u >= 1024) break;
            const int g = u & 3, qb = (u >> 2) & 63, kvh = (u >> 8) & 1, b = u >> 9, hq = kvh * 4 + g;
            const bf16* base = PROJ0 + (size_t)b * SEQ * L0_IN;
            if (ATT_GQA_F8) att::attn_unit_f8<0, ATT_SD0, (GQA_KIMG != 0)>(base + (size_t)(qb * 256) * L0_IN + hq * HD, L0_IN, GQA_KIMG ? (const bf16*)(K8T + (size_t)(b * 2 + kvh) * 256 * 8192) : base + 1024 + kvh * HD, L0_IN, V8T + (size_t)(b * 2 + kvh) * 256 * 8192,
                              MIX + ((size_t)b * SEQ + qb * 256) * DM + hq * HD, DM, SEQ / 64, 0, 0.f, 0.f, (char*)lds + RING_OFF);
            else att::attn_unit<0, ATT_SD0, ATT_QK8_GQA>(base + (size_t)(qb * 256) * L0_IN + hq * HD, L0_IN, base + 1024 + kvh * HD, base + 1280 + kvh * HD, L0_IN,
                              MIX + ((size_t)b * SEQ + qb * 256) * DM + hq * HD, DM, nullptr, 0, SEQ / 64, 0.f, 0.f, (char*)lds + RING_OFF);
        }
        }
        if (P3_PART & 2) {
        gu32* head = F.ctl + CW_Q2 + 256 * rep_;
        for (;;) {
            __syncthreads();
            if (tid == 0) F.MISC[16] = __hip_atomic_fetch_add(head, 1u, RLX_AGENT);
            __syncthreads();
            const int v = __builtin_amdgcn_readfirstlane((int)F.MISC[16]);
            if (v >= 3072) break;
            const int rb = v & 63, h = (v >> 6) & 7, b = (v >> 9) & 1, p = v >> 10;
            const int dil = p == 0 ? 1 : p == 1 ? 4 : 16, L = SEQ / dil, nblk = L / 256, res = rb / nblk, blk = rb % nblk;
            const int q0 = blk * 256; int ks = q0 - 64; ks = ks < 0 ? 0 : ks; ks = ks > L - 384 ? L - 384 : ks;
            const bf16* base = PROJ0 + (size_t)b * SEQ * L0_IN;
            const float slope = exp2f(-(float)(h + 1));
            att::attn_unit<2, ATT_SD2, ATT_QK8_DIL>(base + (size_t)(q0 * dil + res) * L0_IN + 1536 + h * HD, dil * L0_IN,
                              base + (size_t)(ks * dil + res) * L0_IN + 2560 + h * HD, base + (size_t)(ks * dil + res) * L0_IN + 3584 + h * HD, dil * L0_IN,
                              OB + (size_t)p * T * 1024 + ((size_t)b * SEQ + q0 * dil + res) * 1024 + h * HD, dil * 1024,
                              LSE + (size_t)p * T * 8 + ((size_t)b * SEQ + q0 * dil + res) * 8 + h, dil * 8, 6, (float)(q0 - ks), slope * (float)dil * (1.0f / att::SCALE), (char*)lds + RING_OFF);
        }
        }
    }
    SEAM(3);
#if PROBE_ATT
    for (int rep_ = 0; rep_ < (IN(4) ? 1 : 0); ++rep_) {
        PH_BEGIN;
        bf16* SCR = (bf16*)(arena + A_MIX + 128 * MiB) + (size_t)blockIdx.x * 2 * 256 * 128;
        float* SCRL = (float*)(arena + A_MIX + 256 * MiB) + (size_t)blockIdx.x * 256;
        {
            __syncthreads();
            int mism = 0;
            {
                const int u = (int)blockIdx.x * 4 + ((int)blockIdx.x & 3);
                const int g = u & 3, qb = (u >> 2) & 63, kvh = (u >> 8) & 1, b = u >> 9, hq = kvh * 4 + g;
                const bf16* base = PROJ0 + (size_t)b * SEQ * L0_IN;
                int ntv = SEQ / 64, q0v = qb * 256; asm volatile("" : "+v"(ntv), "+v"(q0v));
                att::attn_unit<1, 2>(base + (size_t)q0v * L0_IN + hq * HD, L0_IN, base + 1024 + kvh * HD, base + 1280 + kvh * HD, L0_IN, SCR, 128, nullptr, 0, ntv, (float)q0v, 0.f, (char*)lds + RING_OFF);
                asm volatile("s_waitcnt vmcnt(0)" ::: "memory"); __syncthreads();
                const bf16* ref = MIX + ((size_t)b * SEQ + qb * 256) * DM + hq * HD;
                int nbad = 0;
                for (int e = tid; e < 256 * 128; e += NWAVES * 64) { const int r = e >> 7, cc = e & 127; const float a_ = bflo((unsigned)ref[(size_t)r * DM + cc]), b_ = bflo((unsigned)SCR[r * 128 + cc]); if (!(fabsf(a_ - b_) <= 0.25f * fabsf(b_) + 0.004f)) ++nbad; }
                if ((ATT_QK8_GQA || ATT_GQA_F8) ? (nbad > 8) : (nbad > 0)) mism = 1;
            }
            if (mism) __hip_atomic_fetch_or(F.ctl + CW_PROBE, 1u, RLX_AGENT);
        }
        {
            __syncthreads();
            int mism = 0;
            {
                bf16* const SCR2 = SCR + 256 * 128;
                const int v = (int)blockIdx.x * 12 + ((int)blockIdx.x % 11);
                const int rb = v & 63, h = (v >> 6) & 7, b = (v >> 9) & 1, p = v >> 10;
                const int dil = p == 0 ? 1 : p == 1 ? 4 : 16, L = SEQ / dil, nblk = L / 256, res = rb / nblk, blk = rb % nblk;
                int q0 = blk * 256; int ks = q0 - 64; ks = ks < 0 ? 0 : ks; ks = ks > L - 384 ? L - 384 : ks;
                int ntv = 6; asm volatile("" : "+v"(ntv), "+v"(q0), "+v"(ks));
                const bf16* base = PROJ0 + (size_t)b * SEQ * L0_IN;
                const float slope = exp2f(-(float)(h + 1));
                att::attn_unit<2, 2>(base + (size_t)(q0 * dil + res) * L0_IN + 1536 + h * HD, dil * L0_IN,
                                  base + (size_t)(ks * dil + res) * L0_IN + 2560 + h * HD, base + (size_t)(ks * dil + res) * L0_IN + 3584 + h * HD, dil * L0_IN,
                                  SCR2, 128, SCRL, 1, ntv, (float)(q0 - ks), slope * (float)dil * (1.0f / att::SCALE), (char*)lds + RING_OFF);
                asm volatile("s_waitcnt vmcnt(0)" ::: "memory"); __syncthreads();
                const bf16* ref = OB + (size_t)p * T * 1024 + ((size_t)b * SEQ + q0 * dil + res) * 1024 + h * HD;
                const float* refl = LSE + (size_t)p * T * 8 + ((size_t)b * SEQ + q0 * dil + res) * 8 + h;
                for (int e = tid; e < 256 * 128; e += NWAVES * 64) { const int r = e >> 7, cc = e & 127; if (ref[(size_t)r * dil * 1024 + cc] != SCR2[r * 128 + cc]) mism = 1; }
                if (tid < 256) { if (refl[(size_t)tid * dil * 8] != SCRL[tid]) mism = 1; }
            }
            if (mism) __hip_atomic_fetch_or(F.ctl + CW_PROBE, 1u, RLX_AGENT);
        }
    }
#endif
    for (int rep_ = 0; rep_ < (IN(4) ? REPS(4) : 0); ++rep_) {
        PH_BEGIN;
        for (int t = gw; t < T; t += NGW) {
#pragma unroll
            for (int jj = 0; jj < 2; ++jj) { const int col = 8 * (lane + 64 * jj), h = col >> 7;
                const float l0 = LSE[(size_t)t * 8 + h], l1 = LSE[(size_t)T * 8 + (size_t)t * 8 + h], l2 = LSE[(size_t)2 * T * 8 + (size_t)t * 8 + h];
                const float mx = fmaxf(l0, fmaxf(l1, l2)); float e0 = __expf(l0 - mx), e1 = __expf(l1 - mx), e2 = __expf(l2 - mx); const float inv = 1.f / (e0 + e1 + e2); e0 *= inv; e1 *= inv; e2 *= inv;
                float a[8], b8[8], c8[8], o[8];
                unpack8(*(const v4u*)(OB + (size_t)t * 1024 + col), a); unpack8(*(const v4u*)(OB + (size_t)T * 1024 + (size_t)t * 1024 + col), b8); unpack8(*(const v4u*)(OB + (size_t)2 * T * 1024 + (size_t)t * 1024 + col), c8);
#pragma unroll
                for (int i = 0; i < 8; ++i) o[i] = e0 * a[i] + e1 * b8[i] + e2 * c8[i];
                *(v4u*)(MIX + (size_t)t * DM + 1024 + col) = pack8(o); }
        }
    }
    SEAM(4);
#if PROBE_BARS
    for (int xb_ = 0; xb_ < PROBE_BARS; ++xb_) GRID_BAR();
#endif
    for (int rep_ = 0; rep_ < (IN(5) ? REPS(5) : 0); ++rep_) {
        PH_BEGIN;
        pg8::Gemm g{MIX, W_OUT0, T, DM, DM}; pg8::StaticOrder S; S.init(T, DM, F.G, (int)blockIdx.x);
        pg8::EpiRes E{INP(0), outp, DM};
        pg8::gemm_phase<pg8::EpiRes, pg8::StaticOrder, true, true>(F.lds + RING_OFF, g, S, E);
    }
    SEAM(5);
    for (int rep_ = 0; rep_ < (IN(6) ? REPS(6) : 0); ++rep_) { PH_BEGIN; if (FFN0_F8) { for (int m = gw; m < T; m += NGW) rms_row_to_fp8(outp + (size_t)m * DM, INP(8), (unsigned char*)H + (size_t)m * DM, lane); } else norm_rows_phase(gw, NGW, lane, outp, INP(8), H); }
    SEAM(6);
    for (int rep_ = 0; rep_ < (IN(7) ? REPS(7) : 0); ++rep_) {
        PH_BEGIN;
        pg8::Gemm g{H, W_GU0, T, 2 * FF0, FFN0_F8 ? DM / 2 : DM}; pg8::StaticOrder S; S.init(T, 2 * FF0, F.G, (int)blockIdx.x);
        pg8::EpiSwiglu E{ACT0, FF0, FFN0_F8 ? 1.f / SC_WGU : 1.f};
        pg8::gemm_phase<pg8::EpiSwiglu, pg8::StaticOrder, true, true, (FFN0_F8 != 0)>(F.lds + RING_OFF, g, S, E);
    }
    SEAM(7);
    for (int rep_ = 0; rep_ < (IN(8) ? REPS(8) : 0); ++rep_) {
        PH_BEGIN;
        pg8::Gemm g{ACT0, W_D0, T, DM, FF0}; pg8::StaticOrder S; S.init(T, DM, F.G, (int)blockIdx.x);
        pg8::EpiRes E{outp, outp, DM};
        pg8::gemm_phase<pg8::EpiRes, pg8::StaticOrder, true, true>(F.lds + RING_OFF, g, S, E);
    }
    SEAM(8);
    for (int rep_ = 0; rep_ < (IN(9) ? REPS(9) : 0); ++rep_) { PH_BEGIN; norm_rows_phase(gw, NGW, lane, outp, INP(12), H); }
    SEAM(9);
    for (int rep_ = 0; rep_ < (IN(10) ? REPS(10) : 0); ++rep_) {
        PH_BEGIN;
        pg8::Gemm g{H, W_IN1, T, L1_IN, DM}; pg8::StaticOrder S; S.init(T, L1_IN, F.G, (int)blockIdx.x);
        pg8::EpiBf16 E{PROJ1, L1_IN, 1.f};
        pg8::gemm_phase<pg8::EpiBf16, pg8::StaticOrder, true, true>(F.lds + RING_OFF, g, S, E);
    }
    SEAM(10);
    for (int rep_ = 0; rep_ < (IN(11) ? REPS(11) : 0); ++rep_) {
        PH_BEGIN;
        const int sub = lane >> 4, j = lane & 15;
        const f32x4 qa = *(const f32x4*)(INP(14) + j * 8), qb4 = *(const f32x4*)(INP(14) + j * 8 + 4), ka = *(const f32x4*)(INP(15) + j * 8), kb4 = *(const f32x4*)(INP(15) + j * 8 + 4);
        unsigned* wtab = (unsigned*)(F.ctl + CW_WIN);
        LAS unsigned* lst = (LAS unsigned*)(F.lds + RING_OFF);
        constexpr int NC8 = (DIFF_KIMG && DIFF_F8_HMIN < 8) ? 2 * (8 - DIFF_F8_HMIN) : 0;
        LAS unsigned char* kimg = F.lds + RING_OFF + 4096;
        for (int c = blockIdx.x; c < 256; c += F.G) {
            __syncthreads();
            if (tid < 48) lst[tid] = 0u;
            __syncthreads();
            float mq[4] = {0.f, 0.f, 0.f, 0.f}, mb[4] = {0.f, 0.f, 0.f, 0.f}, mk[4] = {0.f, 0.f, 0.f, 0.f};
            for (int i = wave; i < 128; i += NWAVES) {
                const int t = c * 128 + i;
                bf16* row = PROJ1 + (size_t)t * L1_IN;
                float qv[4][8]; float nq2[4];
#pragma unroll
                for (int it = 0; it < 8; ++it) {
                    const int head = it * 4 + sub; bf16* p = row + head * HD + j * 8;
                    const v4u w = *(const v4u*)p; float v[8]; unpack8(w, v);
                    float ss = 0.f;
#pragma unroll
                    for (int i2 = 0; i2 < 8; ++i2) ss += v[i2] * v[i2];
                    ss += __shfl_xor(ss, 1); ss += __shfl_xor(ss, 2); ss += __shfl_xor(ss, 4); ss += __shfl_xor(ss, 8);
                    const float rstd = rsqrtf(ss * (1.f / HD) + NORM_EPS);
                    const f32x4 ga = it < 4 ? qa : ka, gb = it < 4 ? qb4 : kb4;
                    v[0] *= rstd * ga.x; v[1] *= rstd * ga.y; v[2] *= rstd * ga.z; v[3] *= rstd * ga.w; v[4] *= rstd * gb.x; v[5] *= rstd * gb.y; v[6] *= rstd * gb.z; v[7] *= rstd * gb.w;
                    const v4u pw = pack8(v);
                    *(v4u*)p = pw;
                    float vr[8]; unpack8(pw, vr);
                    float n2 = 0.f, dt = 0.f;
#pragma unroll
                    for (int i2 = 0; i2 < 8; ++i2) { n2 += vr[i2] * vr[i2]; if (it >= 4) dt += vr[i2] * qv[it & 3][i2]; else qv[it & 3][i2] = vr[i2]; }
                    n2 += __shfl_xor(n2, 1); n2 += __shfl_xor(n2, 2); n2 += __shfl_xor(n2, 4); n2 += __shfl_xor(n2, 8);
                    if (it < 4) nq2[it] = n2;
                    else {
                        dt += __shfl_xor(dt, 1); dt += __shfl_xor(dt, 2); dt += __shfl_xor(dt, 4); dt += __shfl_xor(dt, 8);
                        mq[it & 3] = fmaxf(mq[it & 3], sqrtf(nq2[it & 3])); mb[it & 3] = fmaxf(mb[it & 3], 64.f - dt * att::SCALE); mk[it & 3] = fmaxf(mk[it & 3], sqrtf(n2));
                        if (NC8 > 0) { const int comp = (it - 4) * 4 + sub;
                            if (comp >= 16 - NC8) { unsigned lo8, hi8; att::bf8_to_f8(__builtin_bit_cast(att::bf16x8, pw), lo8, hi8); typedef unsigned u32x2_ __attribute__((ext_vector_type(2)));
                                *(LAS u32x2_*)(kimg + (((i >> 6) * NC8 + (comp - (16 - NC8))) * 8192 + att::k8off(i & 63, j >> 1) + (j & 1) * 8)) = (u32x2_){lo8, hi8}; } }
                    }
                }
            }
            if (j == 0) {
#pragma unroll
                for (int q = 0; q < 4; ++q) { const int comp = q * 4 + sub;
                    __hip_atomic_fetch_max(lst + comp, __float_as_uint(mq[q]), __ATOMIC_RELAXED, __HIP_MEMORY_SCOPE_WORKGROUP);
                    __hip_atomic_fetch_max(lst + 16 + comp, __float_as_uint(mb[q]), __ATOMIC_RELAXED, __HIP_MEMORY_SCOPE_WORKGROUP);
                    __hip_atomic_fetch_max(lst + 32 + comp, __float_as_uint(mk[q]), __ATOMIC_RELAXED, __HIP_MEMORY_SCOPE_WORKGROUP); }
            }
            __syncthreads();
            if (NC8 > 0) { const int bb = c >> 7, t0 = (c & 127) * 2;
                for (int q = tid; q < 2 * NC8 * 512; q += NWAVES * 64) { const int img = q >> 9, tl = img / NC8, cc = 16 - NC8 + img % NC8;
                    *(v4u*)(K8D + ((size_t)((bb * 16 + cc) * 256 + t0 + tl) * 8192 + (q & 511) * 16)) = *(const LAS v4u*)(kimg + (size_t)q * 16); } }
            if (tid < 48) { const int which = tid >> 4, comp = tid & 15, bb = c >> 7, qblk = (c & 127) >> 1; const unsigned v = lst[tid];
                if (which == 0) atomicMax(wtab + (bb * 16 + comp) * 64 + qblk, v);
                else if (which == 1) atomicMax(wtab + 2048 + (bb * 16 + comp) * 64 + qblk, v);
                else atomicMax(wtab + 4096 + bb * 16 + comp, v); }
        }
        if (DIFF_F8_HMIN < 8) {
            __syncthreads();
            constexpr int NH8 = 8 - DIFF_F8_HMIN;
            for (int q = gw; q < 2 * NH8 * 2 * 256; q += NGW) { const int t = q & 255, vh = (q >> 8) & 1, hh = (q >> 9) % NH8, b = (q >> 9) / NH8, h = DIFF_F8_HMIN + hh;
                att::v8t_tile(PROJ1 + ((size_t)b * SEQ + t * 64) * L1_IN + 4096 + h * 256 + vh * HD, L1_IN, V8D + (size_t)(((b * 8 + h) * 2 + vh) * 256 + t) * 8192, F.lds + RING_OFF + wave * 16384, lane); }
        }
    }
    SEAM(11);
    for (int rep_ = 0; rep_ < (IN(12) ? REPS(12) : 0); ++rep_) {
        PH_BEGIN;
        const gu32* wtab = F.ctl + CW_WIN;
        if (DIFF_LSE_WIN && N_LAUNCHES == 1) {
            static_assert(DIFF_F8_HMIN >= LSE_H0, "every e4m3-body head takes its window statistics from the pre-pass");
            const int sr = tid >> 4, sc = (tid & 15) * 8, wv = tid >> 6, r32 = lane & 31, hi = lane >> 5;
            att::bf16x8 ks[8], qr[8], ksn[8], qrn[8];
#define LSE_LOAD(KS_, QR_, u_) do { const int qb_ = (u_) & 63, comp_ = 2 * LSE_H0 + ((u_) >> 6) % LSE_NC, b_ = ((u_) >> 6) / LSE_NC; const bf16* blk_ = PROJ1 + ((size_t)b_ * SEQ + qb_ * 256) * L1_IN + comp_ * HD; \
                _Pragma("unroll") for (int i = 0; i < 8; ++i) KS_[i] = *reinterpret_cast<const att::bf16x8*>(blk_ + 2048 + (unsigned)((32 * i + sr) * L1_IN + sc)); \
                _Pragma("unroll") for (int d0 = 0; d0 < 8; ++d0) QR_[d0] = *reinterpret_cast<const att::bf16x8*>(blk_ + (unsigned)((wv * 32 + r32) * L1_IN + hi * 8 + d0 * 16)); } while (0)
            if ((int)blockIdx.x < 128 * LSE_NC) LSE_LOAD(ksn, qrn, (int)blockIdx.x);
            for (int u = blockIdx.x; u < 128 * LSE_NC; u += F.G) {
                const int qb = u & 63, comp = 2 * LSE_H0 + (u >> 6) % LSE_NC, b = (u >> 6) / LSE_NC;
#pragma unroll
                for (int i = 0; i < 8; ++i) { ks[i] = ksn[i]; qr[i] = qrn[i]; }
                asm volatile("s_waitcnt vmcnt(0)" ::: "memory");
                __syncthreads();
                if (u + F.G < 128 * LSE_NC) LSE_LOAD(ksn, qrn, u + F.G);
                const float slope = exp2f(-(float)((comp >> 1) + 1));
                const bool f8c = comp >= 2 * DIFF_F8_HMIN;
                float qn2 = 0.f, kn2 = 0.f;
                if (f8c) {
#pragma unroll
                    for (int i = 0; i < 8; ++i) { qr[i] = att::round_f8(qr[i], qn2); float kn = 0.f; ks[i] = att::round_f8(ks[i], kn);
                        kn += __shfl_xor(kn, 1); kn += __shfl_xor(kn, 2); kn += __shfl_xor(kn, 4); kn += __shfl_xor(kn, 8); kn2 = fmaxf(kn2, kn); }
                    qn2 += __shfl_xor(qn2, 32);
                    qn2 = fmaxf(qn2, __shfl_xor(qn2, 1)); qn2 = fmaxf(qn2, __shfl_xor(qn2, 2)); qn2 = fmaxf(qn2, __shfl_xor(qn2, 4)); qn2 = fmaxf(qn2, __shfl_xor(qn2, 8)); qn2 = fmaxf(qn2, __shfl_xor(qn2, 16));
                    kn2 = fmaxf(kn2, __shfl_xor(kn2, 16)); kn2 = fmaxf(kn2, __shfl_xor(kn2, 32));
                }
                float v = att::lse_block(ks, qr, slope * (1.0f / att::SCALE), (char*)lds + RING_OFF);
                v = fminf(v, __shfl_xor(v, 1)); v = fminf(v, __shfl_xor(v, 2)); v = fminf(v, __shfl_xor(v, 4)); v = fminf(v, __shfl_xor(v, 8)); v = fminf(v, __shfl_xor(v, 16));
                LAS float* red = (LAS float*)(F.lds + RING_OFF + 65536);
                if (lane == 0) { red[wave] = v; red[8 + wave] = qn2; red[16 + wave] = kn2; }
                __syncthreads();
                if (tid == 0) { float mn = red[0], qm = red[8], km = red[16];
#pragma unroll
                    for (int k = 1; k < NWAVES; ++k) { mn = fminf(mn, red[k]); qm = fmaxf(qm, red[8 + k]); km = fmaxf(km, red[16 + k]); }
                    __hip_atomic_store((gu32*)wtab + 4608 + (b * 16 + comp) * 64 + qb, __float_as_uint(mn), RLX_AGENT);
                    if (f8c) { __hip_atomic_store((gu32*)wtab + 6656 + (b * 16 + comp) * 64 + qb, __float_as_uint(sqrtf(qm)), RLX_AGENT);
                        atomicMax((unsigned*)wtab + 8704 + b * 16 + comp, __float_as_uint(sqrtf(km))); } }
            }
#undef LSE_LOAD
            GRID_BAR();
        }
#define WLD(i) __uint_as_float((unsigned)__builtin_amdgcn_readfirstlane((int)__hip_atomic_load((const gu32*)wtab + (i), RLX_AGENT)))
#if PROBE_ATT
#define WIN_PROBE(F8_) { const float sp0_ = ((F8_ ? 1.258f : 1.f) * qmx * kmx * att::SCALE - smin) * 1.001f + 0.01f; if (tid == 0 && (spread > sp0_ + 1e-3f || spread < 0.25f * sp0_)) __hip_atomic_fetch_or(F.ctl + CW_PROBE, 2u, RLX_AGENT); }
#else
#define WIN_PROBE(F8_)
#endif
#define DIFF_WINDOW(F8_) \
            const float slope = exp2f(-(float)(h + 1)); const int comp = h * 2 + c; \
            const float qmx = WLD((b * 16 + comp) * 64 + qb), smin = 64.f - WLD(2048 + (b * 16 + comp) * 64 + qb), kmx = WLD(4096 + b * 16 + comp); \
            float qmx_ = qmx, kmx_ = kmx, smin_ = smin, fac_ = F8_ ? 1.258f : 1.f; \
            if (DIFF_LSE_WIN && N_LAUNCHES == 1 && h >= LSE_H0) { const float lmin = WLD(4608 + (b * 16 + comp) * 64 + qb) - 0.125f; \
                if (F8_) { qmx_ = WLD(6656 + (b * 16 + comp) * 64 + qb); kmx_ = WLD(8704 + b * 16 + comp); smin_ = lmin; fac_ = 1.f; } else smin_ = fmaxf(smin_, lmin); }     \
            asm volatile("" : "+v"(qmx_), "+v"(kmx_), "+v"(smin_));     \
              \
            const float spread = (fac_ * qmx_ * kmx_ * att::SCALE - smin_) * 1.001f + 0.01f; \
            const float wf = (spread + __logf(2.f / ((1.f - __expf(-slope)) * 5.9604645e-8f))) / slope; \
            WIN_PROBE(F8_) \
            const int w = wf >= (float)SEQ ? SEQ : (int)wf + 1; \
            const int q0 = qb * 256; \
            int tlo = q0 - w; tlo = tlo < 0 ? 0 : tlo >> 6; int thi = q0 + 256 + w; thi = thi >= SEQ ? SEQ / 64 : (thi + 63) >> 6; \
            if ((thi - tlo) & 1) { if (thi < SEQ / 64) ++thi; else --tlo; } \
            const bf16* base = PROJ1 + (size_t)b * SEQ * L1_IN;
        if (DIFF_F8_HMIN < 8) {
        gu32* head = F.ctl + CW_Q1 + 256 * rep_;
        for (;;) {
            __syncthreads();
            if (tid == 0) F.MISC[16] = __hip_atomic_fetch_add(head, 1u, RLX_AGENT);
            __syncthreads();
            const int u = __builtin_amdgcn_readfirstlane((int)F.MISC[16]);
            if (u >= (8 - DIFF_F8_HMIN) * (DIFF_F8_DV2 ? 256 : 512)) break;
            int h, qb, vh, c, b;
            if (DIFF_F8_DV2) { h = 7 - (u >> 8); qb = u & 63; vh = 0; c = (u >> 6) & 1; b = (u >> 7) & 1; }
            else { h = 7 - (u >> 9); qb = u & 63; vh = (u >> 6) & 1; c = (u >> 7) & 1; b = (u >> 8) & 1; }
            DIFF_WINDOW(true)
            if (DIFF_F8_DV2) att::attn_unit_f8_dv2<1, ATT_SD1F, (DIFF_KIMG != 0)>(base + (size_t)q0 * L1_IN + (h * 2 + c) * HD, L1_IN,
                              DIFF_KIMG ? (const bf16*)(K8D + (size_t)((b * 16 + h * 2 + c) * 256) * 8192) : base + (size_t)(tlo * 64) * L1_IN + 2048 + (h * 2 + c) * HD, L1_IN,
                              V8D + (size_t)(((b * 8 + h) * 2 + 0) * 256) * 8192, V8D + (size_t)(((b * 8 + h) * 2 + 1) * 256) * 8192,
                              OC + (size_t)c * T * DM + ((size_t)b * SEQ + q0) * DM + h * 256, DM, thi - tlo, tlo, (float)(q0 - tlo * 64), slope * (1.0f / att::SCALE), (char*)lds + RING_OFF);
            else att::attn_unit_f8<1, ATT_SD1>(base + (size_t)q0 * L1_IN + (h * 2 + c) * HD, L1_IN, base + (size_t)(tlo * 64) * L1_IN + 2048 + (h * 2 + c) * HD, L1_IN,
                              V8D + (size_t)(((b * 8 + h) * 2 + vh) * 256) * 8192,
                              OC + (size_t)c * T * DM + ((size_t)b * SEQ + q0) * DM + h * 256 + vh * HD, DM, thi - tlo, tlo, (float)(q0 - tlo * 64), slope * (1.0f / att::SCALE), (char*)lds + RING_OFF);
        }
        }
        {
        gu32* head = F.ctl + CW_Q3 + 256 * rep_;
        for (;;) {
            __syncthreads();
            if (tid == 0) F.MISC[16] = __hip_atomic_fetch_add(head, 1u, RLX_AGENT);
            __syncthreads();
            const int u = __builtin_amdgcn_readfirstlane((int)F.MISC[16]);
            if (u >= DIFF_F8_HMIN * 512) break;
            const int h = DIFF_F8_HMIN - 1 - (u >> 9), qb = u & 63, vh = (u >> 6) & 1, c = (u >> 7) & 1, b = (u >> 8) & 1;
            DIFF_WINDOW(false)
            att::attn_unit<1, ATT_SD1, ATT_QK8_DIFF>(base + (size_t)q0 * L1_IN + (h * 2 + c) * HD, L1_IN,
                              base + (size_t)(tlo * 64) * L1_IN + 2048 + (h * 2 + c) * HD, base + (size_t)(tlo * 64) * L1_IN + 4096 + h * 256 + vh * HD, L1_IN,
                              OC + (size_t)c * T * DM + ((size_t)b * SEQ + q0) * DM + h * 256 + vh * HD, DM, nullptr, 0, thi - tlo, (float)(q0 - tlo * 64), slope * (1.0f / att::SCALE), (char*)lds + RING_OFF);
        }
        }
#undef DIFF_WINDOW
#undef WIN_PROBE
#undef WLD
    }
    SEAM(12);
    for (int rep_ = 0; rep_ < (IN(13) ? REPS(13) : 0); ++rep_) {
        PH_BEGIN;
        float lam;
        { const float a = INP(16)[lane] * INP(17)[lane] + INP(16)[lane + 64] * INP(17)[lane + 64], b2 = INP(18)[lane] * INP(19)[lane] + INP(18)[lane + 64] * INP(19)[lane + 64];
          lam = expf(wave_sum(a)) - expf(wave_sum(b2)) + LAMBDA_INIT; }
        for (int t = gw; t < T; t += NGW) {
#pragma unroll
            for (int jj = 0; jj < 4; ++jj) { const int col = 8 * (lane + 64 * jj);
                float a[8], b8[8], v[8]; unpack8(*(const v4u*)(OC + (size_t)t * DM + col), a); unpack8(*(const v4u*)(OC + (size_t)T * DM + (size_t)t * DM + col), b8);
                float ss = 0.f;
#pragma unroll
                for (int i = 0; i < 8; ++i) { v[i] = a[i] - lam * b8[i]; ss += v[i] * v[i]; }
                ss += __shfl_xor(ss, 1); ss += __shfl_xor(ss, 2); ss += __shfl_xor(ss, 4); ss += __shfl_xor(ss, 8); ss += __shfl_xor(ss, 16);
                const float rstd = rsqrtf(ss * (1.f / 256.f) + NORM_EPS) * (1.f - LAMBDA_INIT);
                const f32x4 ga = *(const f32x4*)(INP(20) + (col & 255)), gb = *(const f32x4*)(INP(20) + (col & 255) + 4);
                v[0] *= rstd * ga.x; v[1] *= rstd * ga.y; v[2] *= rstd * ga.z; v[3] *= rstd * ga.w; v[4] *= rstd * gb.x; v[5] *= rstd * gb.y; v[6] *= rstd * gb.z; v[7] *= rstd * gb.w;
                *(v4u*)(H + (size_t)t * DM + col) = pack8(v); }
        }
    }
    SEAM(13);
    for (int rep_ = 0; rep_ < (IN(14) ? REPS(14) : 0); ++rep_) {
        PH_BEGIN;
        pg8::Gemm g{H, W_OUT1, T, DM, DM}; pg8::StaticOrder S; S.init(T, DM, F.G, (int)blockIdx.x);
        pg8::EpiRes E{outp, outp, DM};
        pg8::gemm_phase<pg8::EpiRes, pg8::StaticOrder, true, true>(F.lds + RING_OFF, g, S, E);
    }
    SEAM(14);
    for (int rep_ = 0; rep_ < (IN(15) ? REPS(15) : 0); ++rep_) {
        PH_BEGIN;
        LAS float* WrT = (LAS float*)(F.lds + RING_OFF);
        LAS int* lcnt = (LAS int*)(F.lds + RING_OFF + 65536);
        for (int c = blockIdx.x; c < 256; c += F.G) {
            __syncthreads();
            for (int k = tid; k < DM; k += NWAVES * 64) { const f32x4 w0 = *(const f32x4*)(INP(23) + k * 8), w1 = *(const f32x4*)(INP(23) + k * 8 + 4);
                WrT[0 * DM + k] = w0.x; WrT[1 * DM + k] = w0.y; WrT[2 * DM + k] = w0.z; WrT[3 * DM + k] = w0.w; WrT[4 * DM + k] = w1.x; WrT[5 * DM + k] = w1.y; WrT[6 * DM + k] = w1.z; WrT[7 * DM + k] = w1.w; }
            if (tid < 8) lcnt[tid] = 0;
            __syncthreads();
            const f32x4* gr = (const f32x4*)INP(22) + lane;
#define ROW_LOAD(V_, i_) do { const f32x4* xr_ = (const f32x4*)(outp + (size_t)(c * 128 + (i_)) * DM) + lane; _Pragma("unroll") for (int j = 0; j < 8; ++j) V_[j] = xr_[64 * j]; } while (0)
#define TOP2_OUT(LG_, t_) do { int e0 = 0; float v0 = LG_[0]; \
                _Pragma("unroll") for (int e = 1; e < 8; ++e) if (LG_[e] > v0) { v0 = LG_[e]; e0 = e; } \
                int e1 = -1; float v1 = -3.0e38f; \
                _Pragma("unroll") for (int e = 0; e < 8; ++e) if (e != e0 && LG_[e] > v1) { v1 = LG_[e]; e1 = e; } \
                const float g1 = 1.f / (1.f + expf(v0 - v1)), g0 = 1.f - g1; \
                if (lane == 0) { TOKE[t_] = (i32x2){e0, e1}; TOKG[t_] = (f32x2){g0, g1}; __hip_atomic_fetch_add(lcnt + e0, 1, __ATOMIC_RELAXED, __HIP_MEMORY_SCOPE_WORKGROUP); __hip_atomic_fetch_add(lcnt + e1, 1, __ATOMIC_RELAXED, __HIP_MEMORY_SCOPE_WORKGROUP); } } while (0)
#define PAIR(VA_, VB_, ia_, ib_) do { const int ta = c * 128 + (ia_), tb = c * 128 + (ib_); float sa = 0.f, sb = 0.f; \
                _Pragma("unroll") for (int j = 0; j < 8; ++j) { sa += (VA_[j].x * VA_[j].x + VA_[j].y * VA_[j].y) + (VA_[j].z * VA_[j].z + VA_[j].w * VA_[j].w); sb += (VB_[j].x * VB_[j].x + VB_[j].y * VB_[j].y) + (VB_[j].z * VB_[j].z + VB_[j].w * VB_[j].w); } \
                const float ra = rsqrtf(wave_sum(sa) * (1.f / DM) + NORM_EPS), rb = rsqrtf(wave_sum(sb) * (1.f / DM) + NORM_EPS); \
                unsigned* oa = (unsigned*)(HFB + (size_t)ta * DM) + lane; unsigned* ob = (unsigned*)(HFB + (size_t)tb * DM) + lane; \
                float la[8] = {0.f, 0.f, 0.f, 0.f, 0.f, 0.f, 0.f, 0.f}, lb[8] = {0.f, 0.f, 0.f, 0.f, 0.f, 0.f, 0.f, 0.f}; \
                _Pragma("unroll") for (int j = 0; j < 8; ++j) { const f32x4 gg = gr[64 * j]; f32x4 ha, hb; \
                    ha.x = VA_[j].x * ra * gg.x; ha.y = VA_[j].y * ra * gg.y; ha.z = VA_[j].z * ra * gg.z; ha.w = VA_[j].w * ra * gg.w; \
                    hb.x = VB_[j].x * rb * gg.x; hb.y = VB_[j].y * rb * gg.y; hb.z = VB_[j].z * rb * gg.z; hb.w = VB_[j].w * rb * gg.w; \
                    oa[64 * j] = pk4_fp8(ha.x, ha.y, ha.z, ha.w); ob[64 * j] = pk4_fp8(hb.x, hb.y, hb.z, hb.w); \
                    _Pragma("unroll") for (int e = 0; e < 8; ++e) { const f32x4 wv = *(const LAS f32x4*)(WrT + e * DM + 4 * (lane + 64 * j)); \
                        la[e] += (ha.x * wv.x + ha.y * wv.y) + (ha.z * wv.z + ha.w * wv.w); lb[e] += (hb.x * wv.x + hb.y * wv.y) + (hb.z * wv.z + hb.w * wv.w); } } \
                _Pragma("unroll") for (int e = 0; e < 8; ++e) { la[e] = wave_sum(la[e]); lb[e] = wave_sum(lb[e]); } \
                TOP2_OUT(la, ta); TOP2_OUT(lb, tb); } while (0)
            {
                f32x4 a0[8], b0[8], a1[8], b1[8];
                ROW_LOAD(a0, wave); ROW_LOAD(b0, wave + NWAVES);
#pragma unroll 1
                for (int k = 0; k < 16; k += 4) {
                    ROW_LOAD(a1, wave + NWAVES * (k + 2)); ROW_LOAD(b1, wave + NWAVES * (k + 3));
                    PAIR(a0, b0, wave + NWAVES * k, wave + NWAVES * (k + 1));
                    if (k + 4 < 16) { ROW_LOAD(a0, wave + NWAVES * (k + 4)); ROW_LOAD(b0, wave + NWAVES * (k + 5)); }
                    PAIR(a1, b1, wave + NWAVES * (k + 2), wave + NWAVES * (k + 3));
                }
            }
#undef PAIR
#undef TOP2_OUT
#undef ROW_LOAD
            __syncthreads();
            if (tid < 8) CNT[c * 8 + tid] = lcnt[tid];
        }
    }
    SEAM(15);
    for (int rep_ = 0; rep_ < (IN(16) ? REPS(16) : 0); ++rep_) {
        PH_BEGIN;
        LAS int* tab = (LAS int*)(F.lds + RING_OFF);
        LAS int* bse = tab + 2048;
        LAS int* sel = bse + 8;
        LAS int* dst = sel + 256;
        for (int c = blockIdx.x; c < 256; c += F.G) {
            __syncthreads();
            for (int i = tid; i < 2048; i += NWAVES * 64) tab[i] = CNT[i];
            if (tid < 128) { const i32x2 e = TOKE[c * 128 + tid]; sel[2 * tid] = e.x; sel[2 * tid + 1] = e.y; }
            __syncthreads();
            if (tid < 8) { const int e = tid; int pre = 0, tot = 0;
                for (int cc = 0; cc < 256; ++cc) { const int n = tab[cc * 8 + e]; tot += n; pre += (cc < c) ? n : 0; }
                bse[e] = pre; tab[e] = tot; }
            __syncthreads();
            if (tid < 8) { const int e = tid; int ps = 0;
                for (int k = 0; k < e; ++k) ps += (tab[k] + 255) & ~255;
                int r = ps + bse[e];
                for (int i = 0; i < 256; ++i) if (sel[i] == e) dst[i] = r++;
                if (c == 0) TOT[e] = tab[e]; }
            __syncthreads();
            if (tid < 128) TOKS[c * 128 + tid] = (i32x2){dst[2 * tid], dst[2 * tid + 1]};
            for (int i = wave; i < 128; i += NWAVES) {
                const int t = c * 128 + i; const int s0 = dst[2 * i], s1 = dst[2 * i + 1];
                const v4u* src = (const v4u*)(HFB + (size_t)t * DM) + lane; v4u* d0 = (v4u*)(XS + (size_t)s0 * DM) + lane; v4u* d1 = (v4u*)(XS + (size_t)s1 * DM) + lane;
#pragma unroll
                for (int j = 0; j < 2; ++j) { const v4u w = src[64 * j]; d0[64 * j] = w; d1[64 * j] = w; }
            }
        }
    }
    SEAM(16);
    {
        int cend[8]; int nMt = 0;
        if (IN(17) || IN(18)) {
            PH_BEGIN;
#pragma unroll
            for (int e = 0; e < 8; ++e) { nMt += (__builtin_amdgcn_readfirstlane(__hip_atomic_load((const gu32*)TOT + e, RLX_AGENT)) + 255) >> 8; cend[e] = nMt; }
        }
        for (int rep_ = 0; rep_ < (IN(17) ? REPS(17) : 0); ++rep_) {
            PH_BEGIN;
            pg8::Gemm g{(const bf16*)XS, (const bf16*)W_GUE, nMt * 256, 2 * FFE, DM / 2}; pg8::MoeOrder S; S.init(nMt * 256, 2 * FFE, F.G, (int)blockIdx.x); S.t0 = 0; S.estride = (size_t)2 * FFE * DM;
#pragma unroll
            for (int e = 0; e < 8; ++e) S.cend[e] = cend[e];
            pg8::EpiSwigluF8 E{ACT, FFE, 1.f / SC_WGU, SC_ACT};
            pg8::gemm_phase<pg8::EpiSwigluF8, pg8::MoeOrder, true, true, true>(F.lds + RING_OFF, g, S, E);
        }
        SEAM(17);
        for (int rep_ = 0; rep_ < (IN(18) ? REPS(18) : 0); ++rep_) {
            PH_BEGIN;
            pg8::Gemm g{(const bf16*)ACT, (const bf16*)W_DE, nMt * 256, DM, FFE / 2}; pg8::MoeOrder S; S.init(nMt * 256, DM, F.G, (int)blockIdx.x); S.t0 = 0; S.estride = (size_t)DM * FFE;
#pragma unroll
            for (int e = 0; e < 8; ++e) S.cend[e] = cend[e];
            pg8::EpiBf16 E{Y, DM, 1.f / (SC_ACT * SC_WD)};
            pg8::gemm_phase<pg8::EpiBf16, pg8::MoeOrder, true, true, true>(F.lds + RING_OFF, g, S, E);
        }
        SEAM(18);
    }
    for (int rep_ = 0; rep_ < (IN(19) ? REPS(19) : 0); ++rep_) {
        PH_BEGIN;
#if PROBE_ATT
        const bool probe_bad = __hip_atomic_load(F.ctl + CW_PROBE, RLX_AGENT) != 0u;
#endif
        for (int t = gw; t < T; t += NGW) {
            const i32x2 sl = TOKS[t]; f32x2 gt = TOKG[t];
#if PROBE_ATT
            if (probe_bad) gt.x = __builtin_nanf("");
#endif
            f32x4* xr = (f32x4*)(outp + (size_t)t * DM) + 2 * lane; const v4u* y0 = (const v4u*)(Y + (size_t)sl.x * DM) + lane; const v4u* y1 = (const v4u*)(Y + (size_t)sl.y * DM) + lane;
#pragma unroll
            for (int j = 0; j < 4; ++j) { float a[8], b8[8]; unpack8(y0[64 * j], a); unpack8(y1[64 * j], b8);
                f32x4 x0 = xr[128 * j], x1 = xr[128 * j + 1];
                x0.x += gt.x * a[0] + gt.y * b8[0]; x0.y += gt.x * a[1] + gt.y * b8[1]; x0.z += gt.x * a[2] + gt.y * b8[2]; x0.w += gt.x * a[3] + gt.y * b8[3];
                x1.x += gt.x * a[4] + gt.y * b8[4]; x1.y += gt.x * a[5] + gt.y * b8[5]; x1.z += gt.x * a[6] + gt.y * b8[6]; x1.w += gt.x * a[7] + gt.y * b8[7];
                xr[128 * j] = x0; xr[128 * j + 1] = x1; }
        }
    }
#undef IN
#undef SEAM
#undef GRID_BAR
}

extern "C" void kernel_launch(void* const* d_in, const int* in_sizes, int n_in, void* d_out, int out_size, void* d_ws, size_t ws_size, hipStream_t stream) {
    static int grid = 0;
    if (grid == 0) {
        if (n_in != 27 || in_sizes[0] != T * DM || out_size != T * DM || ws_size < WS_END) { fprintf(stderr, "kernel_launch: shape/workspace mismatch: n_in %d in0 %d out %d ws %zu (need %zu)\n", n_in, n_in > 0 ? in_sizes[0] : -1, out_size, ws_size, (size_t)WS_END); grid = -1; return; }
        int dev = 0, cus = 0, per_cu = 0;
        if (hipGetDevice(&dev) != hipSuccess || hipDeviceGetAttribute(&cus, hipDeviceAttributeMultiprocessorCount, dev) != hipSuccess) { grid = -1; return; }
        if (hipFuncSetAttribute((const void*)mk_fwd, hipFuncAttributeMaxDynamicSharedMemorySize, LDS_BYTES) != hipSuccess) { fprintf(stderr, "kernel_launch: hipFuncSetAttribute failed\n"); grid = -1; return; }
        if (hipOccupancyMaxActiveBlocksPerMultiprocessor(&per_cu, (const void*)mk_fwd, NWAVES * 64, LDS_BYTES) != hipSuccess || per_cu < 1) { fprintf(stderr, "kernel_launch: occupancy query reports %d workgroups per CU\n", per_cu); }
        (void)hipGetLastError();
        grid = cus;
    }
    if (grid < 0) return;
    if (hipMemsetAsync((char*)d_ws + WS_CTL, 0, CTL_ZERO_BYTES, stream) != hipSuccess) return;
    Args a{};
    for (int i = 0; i < 27; ++i) a.in[i] = (const float*)d_in[i];
    a.out = (float*)d_out; a.ws = (unsigned char*)d_ws;
    for (int li = 0; li < N_LAUNCHES; ++li) {
        a.ph_lo = (N_LAUNCHES == 1) ? 0 : li; a.ph_hi = (N_LAUNCHES == 1) ? N_PHASES : li + 1;
        hipLaunchKernelGGL(mk_fwd, dim3(grid), dim3(NWAVES * 64), LDS_BYTES, stream, a);
        const hipError_t le = hipPeekAtLastError();
        if (le != hipSuccess) { fprintf(stderr, "kernel_launch: launch %d failed: %s\n", li, hipGetErrorName(le)); break; }
    }
}
```
